# Optimizing an MI355X kernel written in HIP

```python
import jax, jax.numpy as jnp
from jax import lax
import numpy as np

D_MODEL = 4096
BATCH = 1
SEQ = 16384
DEPTH = 1

RET_HEADS = 8
RET_DV = D_MODEL // (2 * RET_HEADS)
RET_DK = RET_DV // 2
RET_QK = RET_HEADS * RET_DK
RET_WIDTH = RET_HEADS * RET_DV
RET_CHUNK = 128
FOX_HEADS = 16
FOX_DH = D_MODEL // (2 * FOX_HEADS)
FOX_WIDTH = FOX_HEADS * FOX_DH
FOX_BLOCK = 128
MIX_WIDTH = RET_WIDTH + FOX_WIDTH
IN_WIDTH = 2 * RET_QK + 2 * RET_WIDTH + 3 * FOX_WIDTH + FOX_HEADS
ROPE_BASE = 10000.0
PEER_HEADS = 8
PEER_NKEYS = 128
PEER_NEXPERTS = PEER_NKEYS * PEER_NKEYS
PEER_DQ = 256
PEER_TOPK = 16
PEER_CHUNK = 64
EPS = 1e-6

kernel_name = 'hybrid_retention_fox_peer_adaln'


def _in_splits():
    sizes = (RET_QK, RET_QK, RET_WIDTH, RET_WIDTH, FOX_WIDTH, FOX_WIDTH, FOX_WIDTH)
    out, acc = [], 0
    for s in sizes:
        acc += s
        out.append(acc)
    return out


def rmsnorm(x, g):
    xf = x.astype(jnp.float32)
    y = xf * lax.rsqrt(jnp.mean(xf * xf, axis=-1, keepdims=True) + EPS)
    return (y * g.astype(jnp.float32)).astype(x.dtype)


def modulate(h, shift, scale):
    return h * (1.0 + scale[:, None, :]) + shift[:, None, :]


def rotary(x, positions):
    half = x.shape[-1] // 2
    inv_freq = ROPE_BASE ** (-jnp.arange(half, dtype=jnp.float32) / half)
    ang = positions.astype(jnp.float32)[..., None] * inv_freq
    cos = jnp.cos(ang)[:, :, None, :]
    sin = jnp.sin(ang)[:, :, None, :]
    xf = x.astype(jnp.float32)
    x1, x2 = xf[..., :half], xf[..., half:]
    return jnp.concatenate([x1 * cos - x2 * sin, x1 * sin + x2 * cos], axis=-1)


def retention_chunkwise(q, k, v, positions):
    B, S, H, dk = q.shape
    dv = v.shape[-1]
    C = RET_CHUNK
    nc = S // C
    q = rotary(q, positions)
    k = rotary(k, positions) * (dk ** -0.5)
    v = v.astype(jnp.float32)
    log_g = jnp.log1p(-jnp.exp2(-5.0 - jnp.arange(H, dtype=jnp.float32)))

    def chunks(t):
        return t.reshape(B, nc, C, H, t.shape[-1]).transpose(0, 3, 1, 2, 4)

    qc, kc, vc = chunks(q), chunks(k), chunks(v)
    i = jnp.arange(C, dtype=jnp.float32)
    diff = i[:, None] - i[None, :]
    decay_in = jnp.where(diff >= 0, jnp.exp(jnp.maximum(diff, 0.0)[None] * log_g[:, None, None]), 0.0)
    scores = jnp.einsum('bhncd,bhnsd->bhncs', qc, kc) * decay_in[None, :, None]
    intra = jnp.einsum('bhncs,bhnse->bhnce', scores, vc)
    k_dec = kc * jnp.exp((C - 1.0 - i)[None, :] * log_g[:, None])[None, :, None, :, None]
    kv = jnp.einsum('bhncd,bhnce->nbhde', k_dec, vc)
    chunk_decay = jnp.exp(C * log_g)[None, :, None, None]

    def step(state, kv_n):
        return state * chunk_decay + kv_n, state

    _, state_prev = lax.scan(step, jnp.zeros((B, H, dk, dv), jnp.float32), kv)
    q_dec = qc * jnp.exp((i + 1.0)[None, :] * log_g[:, None])[None, :, None, :, None]
    cross = jnp.einsum('bhncd,nbhde->bhnce', q_dec, state_prev)
    return (intra + cross).transpose(0, 2, 3, 1, 4).reshape(B, S, H, dv)


def forgetting_attention(q, k, v, f_logit, b_forget):
    B, S, H, dh = q.shape
    nq = S // FOX_BLOCK
    scale = dh ** -0.5
    log_f = jax.nn.log_sigmoid(f_logit.astype(jnp.float32) + b_forget.astype(jnp.float32))
    cum = jnp.cumsum(log_f, axis=1).transpose(0, 2, 1)
    pos = jnp.arange(S)
    q_blocks = q.reshape(B, nq, FOX_BLOCK, H, dh).transpose(1, 0, 2, 3, 4)
    c_blocks = cum.reshape(B, H, nq, FOX_BLOCK).transpose(2, 0, 1, 3)
    p_blocks = pos.reshape(nq, FOX_BLOCK)

    def block(args):
        q_i, c_i, p_i = args
        logits = jnp.einsum('bqhd,bkhd->bhqk', q_i, k, preferred_element_type=jnp.float32) * scale
        logits = logits + (c_i[..., :, None] - cum[..., None, :])
        causal = p_i[:, None] >= pos[None, :]
        probs = jax.nn.softmax(jnp.where(causal, logits, -jnp.inf), axis=-1)
        return jnp.einsum('bhqk,bkhd->bqhd', probs.astype(v.dtype), v)

    out = lax.map(block, (q_blocks, c_blocks, p_blocks))
    return out.transpose(1, 0, 2, 3, 4).reshape(B, S, H * dh)


def peer_ffn(h, w_q, sub_keys, u, v):
    B, S, D = h.shape
    T = B * S
    ht = h.reshape(T, D)
    q = (ht @ w_q).reshape(T, PEER_HEADS, 2, PEER_DQ // 2)
    s = jnp.einsum('thpd,hpkd->thpk', q, sub_keys, preferred_element_type=jnp.float32)
    s_top, i_top = lax.top_k(s, PEER_TOPK)
    cand = (s_top[:, :, 0, :, None] + s_top[:, :, 1, None, :]).reshape(T, PEER_HEADS, PEER_TOPK * PEER_TOPK)
    c_top, c_idx = lax.top_k(cand, PEER_TOPK)
    i1 = jnp.take_along_axis(i_top[:, :, 0], c_idx // PEER_TOPK, axis=-1)
    i2 = jnp.take_along_axis(i_top[:, :, 1], c_idx % PEER_TOPK, axis=-1)
    expert = (i1 * PEER_NKEYS + i2).reshape(T, PEER_HEADS * PEER_TOPK)
    gates = jax.nn.softmax(c_top, axis=-1).reshape(T, PEER_HEADS * PEER_TOPK)
    nch = T // PEER_CHUNK

    def block(args):
        h_c, e_c, g_c = args
        u_sel = u[e_c]
        a = jnp.einsum('td,ted->te', h_c, u_sel, preferred_element_type=jnp.float32)
        a = jax.nn.gelu(a) * g_c
        v_sel = v[e_c]
        return jnp.einsum('te,ted->td', a.astype(v_sel.dtype), v_sel)

    out = lax.map(block, (ht.reshape(nch, PEER_CHUNK, D),
                          expert.reshape(nch, PEER_CHUNK, PEER_HEADS * PEER_TOPK),
                          gates.reshape(nch, PEER_CHUNK, PEER_HEADS * PEER_TOPK)))
    return out.reshape(B, S, D).astype(h.dtype)


def setup_inputs(seed: int = 0) -> dict:
    key = jax.random.key(seed)
    ks = jax.random.split(key, 16)
    nrm = jax.random.normal
    x = nrm(ks[0], (BATCH, SEQ, D_MODEL), jnp.float32)
    c = nrm(ks[1], (BATCH, D_MODEL), jnp.float32)
    positions = jnp.broadcast_to(jnp.arange(SEQ, dtype=jnp.int32)[None, :], (BATCH, SEQ))
    w_ada = nrm(ks[2], (DEPTH, D_MODEL, 6 * D_MODEL), jnp.float32) * (0.3 * D_MODEL ** -0.5)
    b_ada = 0.01 * nrm(ks[3], (DEPTH, 6 * D_MODEL), jnp.float32)
    norm1_g = 1.0 + 0.02 * nrm(ks[4], (DEPTH, D_MODEL), jnp.float32)
    w_in = nrm(ks[5], (DEPTH, D_MODEL, IN_WIDTH), jnp.float32) * D_MODEL ** -0.5
    b_forget = jnp.linspace(1.0, 5.0, FOX_HEADS, dtype=jnp.float32)[None, :] + 0.1 * nrm(ks[6], (DEPTH, FOX_HEADS), jnp.float32)
    ret_gn_g = 1.0 + 0.02 * nrm(ks[7], (DEPTH, RET_WIDTH), jnp.float32)
    fox_norm_g = 1.0 + 0.02 * nrm(ks[8], (DEPTH, FOX_WIDTH), jnp.float32)
    w_out = nrm(ks[9], (DEPTH, MIX_WIDTH, D_MODEL), jnp.float32) * MIX_WIDTH ** -0.5
    norm2_g = 1.0 + 0.02 * nrm(ks[10], (DEPTH, D_MODEL), jnp.float32)
    w_peer_q = nrm(ks[11], (DEPTH, D_MODEL, PEER_HEADS * PEER_DQ), jnp.float32) * D_MODEL ** -0.5
    peer_sub_keys = nrm(ks[12], (DEPTH, PEER_HEADS, 2, PEER_NKEYS, PEER_DQ // 2), jnp.float32) * (PEER_DQ // 2) ** -0.5
    peer_u = nrm(ks[13], (DEPTH, PEER_NEXPERTS, D_MODEL), jnp.float32) * D_MODEL ** -0.5
    peer_v = nrm(ks[14], (DEPTH, PEER_NEXPERTS, D_MODEL), jnp.float32) * 0.5
    final_g = 1.0 + 0.02 * nrm(ks[15], (D_MODEL,), jnp.float32)
    return {'x': x, 'c': c, 'positions': positions, 'w_ada': w_ada, 'b_ada': b_ada,
            'norm1_g': norm1_g, 'w_in': w_in, 'b_forget': b_forget, 'ret_gn_g': ret_gn_g,
            'fox_norm_g': fox_norm_g, 'w_out': w_out, 'norm2_g': norm2_g, 'w_peer_q': w_peer_q,
            'peer_sub_keys': peer_sub_keys, 'peer_u': peer_u, 'peer_v': peer_v, 'final_g': final_g}


def reference(x, c, positions, w_ada, b_ada, norm1_g, w_in, b_forget, ret_gn_g, fox_norm_g,
              w_out, norm2_g, w_peer_q, peer_sub_keys, peer_u, peer_v, final_g):
    B, S, D = x.shape
    c_act = jax.nn.silu(c)
    splits = _in_splits()
    for l in range(DEPTH):
        mod = c_act @ w_ada[l] + b_ada[l]
        shift1, scale1, gate1, shift2, scale2, gate2 = jnp.split(mod, 6, axis=-1)
        h = modulate(rmsnorm(x, norm1_g[l]), shift1, scale1)
        proj = h @ w_in[l]
        rq, rk, rv, rg, fq, fk, fv, ff = jnp.split(proj, splits, axis=-1)
        y_ret = retention_chunkwise(rq.reshape(B, S, RET_HEADS, RET_DK), rk.reshape(B, S, RET_HEADS, RET_DK),
                                    rv.reshape(B, S, RET_HEADS, RET_DV), positions)
        mu = jnp.mean(y_ret, axis=-1, keepdims=True)
        var = jnp.mean(jnp.square(y_ret - mu), axis=-1, keepdims=True)
        y_ret = ((y_ret - mu) * lax.rsqrt(var + EPS)).reshape(B, S, RET_WIDTH)
        y_ret = y_ret * ret_gn_g[l].astype(jnp.float32) * jax.nn.silu(rg.astype(jnp.float32))
        y_fox = forgetting_attention(fq.reshape(B, S, FOX_HEADS, FOX_DH), fk.reshape(B, S, FOX_HEADS, FOX_DH),
                                     fv.reshape(B, S, FOX_HEADS, FOX_DH), ff, b_forget[l])
        y_fox = rmsnorm(y_fox, fox_norm_g[l])
        mixed = jnp.concatenate([y_ret.astype(x.dtype), y_fox.astype(x.dtype)], axis=-1) @ w_out[l]
        x = x + gate1[:, None, :] * mixed
        h = modulate(rmsnorm(x, norm2_g[l]), shift2, scale2)
        x = x + gate2[:, None, :] * peer_ffn(h, w_peer_q[l], peer_sub_keys[l], peer_u[l], peer_v[l])
    return rmsnorm(x, final_g)
```

```cpp
#include <hip/hip_runtime.h>
#include <cstdio>
#include <cstdint>

#define DI __device__ __forceinline__
#define LAS __attribute__((address_space(3)))
typedef unsigned short bf16_t;
typedef short bf16x8 __attribute__((ext_vector_type(8)));
typedef float f32x2 __attribute__((ext_vector_type(2)));
typedef float f32x4 __attribute__((ext_vector_type(4)));
typedef float f32x16 __attribute__((ext_vector_type(16)));
typedef unsigned u32x2 __attribute__((ext_vector_type(2)));
typedef unsigned u32x4 __attribute__((ext_vector_type(4)));
typedef __bf16 bf16v2 __attribute__((ext_vector_type(2)));
typedef short s16x4 __attribute__((ext_vector_type(4)));
typedef int i32x4v __attribute__((ext_vector_type(4)));

constexpr int T = 16384, D = 4096, INW = 12304, NPAD = 12288;
constexpr int C_RQ = 0, C_RK = 1024, C_RV = 2048, C_RG = 4096, C_FQ = 6144, C_FK = 8192, C_FV = 10240;
constexpr int LDK = 4160;
constexpr int NTHREADS = 512;
constexpr int LDS_BYTES = 155648;
constexpr int LDS_BAR_OFF = 131072;
constexpr int LDS_MISC_OFF = 131072 + 64;
constexpr float LOG2E = 1.4426950408889634f;
constexpr float EPS = 1e-6f;

constexpr size_t WS_CTL  = 0;
constexpr size_t CTL_BYTES = 65536;
constexpr size_t WS_MOD  = WS_CTL + CTL_BYTES;
constexpr size_t WS_COS  = WS_MOD + 98304;
constexpr size_t WS_SIN  = WS_COS + (size_t)T * 64 * 4;
constexpr size_t WS_SKB  = WS_SIN + (size_t)T * 64 * 4;
constexpr size_t WS_CUM  = WS_SKB + 524288;
constexpr size_t WS_SU   = WS_CUM + (size_t)16 * T * 4;
constexpr size_t WS_SV   = WS_SU + 65536;
constexpr size_t WS_FF   = WS_SV + 65536;
constexpr size_t WS_WIN  = WS_FF + (size_t)T * 16 * 4;
constexpr size_t WS_WOUT = WS_WIN + (size_t)INW * LDK * 2;
constexpr size_t WS_WPQ  = WS_WOUT + (size_t)4096 * LDK * 2;
constexpr size_t WS_UB   = WS_WPQ + (size_t)2048 * LDK * 2;
constexpr size_t WS_VB   = WS_UB + (size_t)16384 * 4096;
constexpr size_t WS_H1   = WS_VB + (size_t)16384 * 4096;
constexpr size_t WS_PROJ = WS_H1 + (size_t)T * LDK * 2;
constexpr size_t WS_KV   = WS_PROJ + (size_t)T * NPAD * 2;
constexpr size_t WS_RQ   = WS_KV + (size_t)128 * 8 * 256 * 128 * 4;
constexpr size_t WS_RK   = WS_RQ + (size_t)T * 1024 * 2;
constexpr size_t WS_RKT  = WS_RK + (size_t)T * 1024 * 2;
constexpr size_t WS_RVT  = WS_RKT + (size_t)T * 1024 * 2;
constexpr size_t WS_FVT  = WS_RVT + (size_t)T * 2048 * 2;
constexpr size_t WS_CSTOT = WS_FVT + (size_t)T * 2048 * 2;
constexpr size_t WS_END  = WS_CSTOT + 32768;
constexpr size_t WS_H2   = WS_PROJ;
constexpr size_t WS_QP   = WS_PROJ + (size_t)T * LDK * 2;
constexpr size_t WS_X1B  = WS_QP + (size_t)T * 2048 * 2;

constexpr int CW_BAR = 0;
constexpr int CW_QUEUE = 8192;
constexpr int CW_KMAX = 8448;
constexpr int CW_CSFLAG = 10240;
constexpr int CW_SCAN = 8704;

DI unsigned pk_bf16(float lo, float hi) { f32x2 v = {lo, hi}; bf16v2 b = __builtin_convertvector(v, bf16v2); return __builtin_bit_cast(unsigned, b); }
DI float bf_lo(unsigned w) { return __uint_as_float(w << 16); }
DI float bf_hi(unsigned w) { return __uint_as_float(w & 0xffff0000u); }
DI float bf2f(bf16_t b) { return __uint_as_float(((unsigned)b) << 16); }
DI bf16_t f2bf(float f) { return (bf16_t)(pk_bf16(f, 0.f) & 0xffffu); }
DI float wave_sum(float v) {
#pragma unroll
    for (int m = 32; m >= 1; m >>= 1) v += __shfl_xor(v, m);
    return v;
}
DI float swap32_max(float x) { auto rr = __builtin_amdgcn_permlane32_swap(__float_as_uint(x), __float_as_uint(x), false, false); return fmaxf(__uint_as_float(rr[0]), __uint_as_float(rr[1])); }
DI float swap32_sum(float x) { auto rr = __builtin_amdgcn_permlane32_swap(__float_as_uint(x), __float_as_uint(x), false, false); return __uint_as_float(rr[0]) + __uint_as_float(rr[1]); }
DI float swap32_other(float x, int hh) { auto rr = __builtin_amdgcn_permlane32_swap(__float_as_uint(x), __float_as_uint(x), false, false); return __uint_as_float(hh ? rr[0] : rr[1]); }
DI int lane_id() { int l; asm volatile("v_mbcnt_lo_u32_b32 %0, -1, 0\n\tv_mbcnt_hi_u32_b32 %0, -1, %0" : "=v"(l)); return l; }
DI int crow(int reg, int hh) { return (reg & 3) + 8 * (reg >> 2) + 4 * hh; }
#define MFMA32(a, b, c) __builtin_amdgcn_mfma_f32_32x32x16_bf16((a), (b), (c), 0, 0, 0)
DI bf16x8 pack8(float a0, float a1, float a2, float a3, float a4, float a5, float a6, float a7) {
    u32x4 w = {pk_bf16(a0, a1), pk_bf16(a2, a3), pk_bf16(a4, a5), pk_bf16(a6, a7)};
    return __builtin_bit_cast(bf16x8, w);
}
DI float dot2bf(unsigned a, unsigned b, float c) { return __builtin_amdgcn_fdot2_f32_bf16(__builtin_bit_cast(bf16v2, a), __builtin_bit_cast(bf16v2, b), c, false); }
DI float silu_f(float x) { return x / (1.f + __expf(-x)); }
DI float gelu_tanh(float x) {
    const float u = 0.7978845608028654f * (x + 0.044715f * x * x * x);
    const float t = 1.f - 2.f / (1.f + __expf(2.f * u));
    return 0.5f * x * (1.f + t);
}

#define XB_TMO      128
#define XB_XCNT(j)  (256  + 64 * (j))
#define XB_XSUB(j)  (1280 + 64 * (j))
#define XB_XGEN(j)  (2304 + 64 * (j))
#define XB_TOP      3328
#define XB_TOPGEN   3392
#define XCD_BAR_WORDS 3456
#define XB_SPIN_CAP (1u << 27)
DI unsigned xb_ld(unsigned* p)              { return __hip_atomic_load(p, __ATOMIC_RELAXED, __HIP_MEMORY_SCOPE_AGENT); }
DI unsigned xb_add(unsigned* p, unsigned v) { return __hip_atomic_fetch_add(p, v, __ATOMIC_RELAXED, __HIP_MEMORY_SCOPE_AGENT); }
DI unsigned xb_xcc_id() { return (unsigned)__builtin_amdgcn_s_getreg((3 << 11) | 20) & 0xFu; }
#define XB_SPIN(cond, bar) do { unsigned _sp = 0; while (cond) { __builtin_amdgcn_s_sleep(1); \
    if ((++_sp & 255u) == 0u) { if (xb_ld(&(bar)[XB_TMO])) break; if (_sp > XB_SPIN_CAP) { atomicAdd(&(bar)[XB_TMO], 1u); break; } } } } while (0)
struct XcdBarrier { unsigned* bar; unsigned x; volatile LAS unsigned* st; int wid; };
DI XcdBarrier xcd_barrier_post(unsigned* bar, volatile LAS unsigned* st) {
    XcdBarrier b; b.bar = bar; b.x = xb_xcc_id(); b.st = st;
    if (threadIdx.x == 0) (void)xb_add(&bar[XB_XCNT(b.x)], 1u);
    return b;
}
DI void xcd_barrier_complete(unsigned* bar, unsigned x, unsigned& nloc, unsigned& nx) {
    const unsigned G = gridDim.x * gridDim.y * gridDim.z;
    unsigned sum, cnt, mine, sp = 0u;
    for (;;) {
        sum = 0u; cnt = 0u; mine = 0u;
#pragma unroll
        for (unsigned j = 0; j < 16; ++j) { const unsigned c = xb_ld(&bar[XB_XCNT(j)]); sum += c; cnt += (c > 0u) ? 1u : 0u; mine = (j == x) ? c : mine; }
        if (sum == G) break;
        __builtin_amdgcn_s_sleep(1);
        if ((++sp & 255u) == 0u) { if (xb_ld(&bar[XB_TMO])) break; if (sp > XB_SPIN_CAP) { atomicAdd(&bar[XB_TMO], 1u); break; } }
    }
    nloc = mine > 0u ? mine : 1u; nx = cnt > 0u ? cnt : 1u;
}
DI void xcd_barrier(const XcdBarrier& b) {
    asm volatile("s_waitcnt vmcnt(0)" ::: "memory");
    __syncthreads();
    if (b.wid == 0 && lane_id() == 0) {
        unsigned* bar = b.bar;
        __builtin_amdgcn_s_waitcnt(0);
        unsigned nloc = b.st[0], nx = b.st[1];
        if (nloc == 0u) { xcd_barrier_complete(bar, b.x, nloc, nx); b.st[0] = nloc; b.st[1] = nx; }
        const unsigned old = xb_add(&bar[XB_XSUB(b.x)], 1u);
        const unsigned gen = old / nloc;
        if (old + 1u == (gen + 1u) * nloc) {
            __builtin_amdgcn_fence(__ATOMIC_RELEASE, "agent");
            asm volatile("s_waitcnt vmcnt(0)" ::: "memory");
            const unsigned og = xb_add(&bar[XB_TOP], 1u);
            const unsigned tg = og / nx;
            if (og + 1u == (tg + 1u) * nx) xb_add(&bar[XB_TOPGEN], 1u);
            else XB_SPIN(xb_ld(&bar[XB_TOPGEN]) == tg, bar);
            __builtin_amdgcn_fence(__ATOMIC_ACQUIRE, "agent");
            xb_add(&bar[XB_XGEN(b.x)], 1u);
            asm volatile("s_waitcnt vmcnt(0)" ::: "memory");
        } else {
            XB_SPIN(xb_ld(&bar[XB_XGEN(b.x)]) == gen, bar);
            __builtin_amdgcn_fence(__ATOMIC_ACQUIRE, "agent");
            asm volatile("s_waitcnt vmcnt(0)" ::: "memory");
        }
    }
    __syncthreads();
}

namespace pg8 {
constexpr int BM = 256, BK = 64, HALF = 128, HTB = HALF * BK * 2, STAGE_BYTES = 8 * HTB, NXCD = 8, WGM = 8;
DI int lds_byte(int r, int c) { const int st = (r >> 4) * 2 + (c >> 5), rr = r & 15, cc = c & 31, ob = rr * 64 + cc * 2; return st * 1024 + (ob ^ (((ob >> 9) & 1) << 5)); }
DI void stage_rc(int b, int& R, int& C) { const int st = b / 1024, sb = b % 1024, swz = sb ^ (((sb >> 9) & 1) << 5); R = (st >> 1) * 16 + swz / 64; C = (st & 1) * 32 + (swz % 64) / 2; }
DI int perm32(int rho) { const int n = rho >> 4, i = rho & 15; return 8 * (i >> 2) + 4 * n + (i & 3); }
struct Unit { int pm, pn; };
struct Gemm { const bf16_t* A; const bf16_t* Bt; int M, N, K, ld; };
struct StaticOrder {
    int nM, nN, nwg, G, c;
    DI void init(int M, int N, int G_, int c_) { nM = M / BM; nN = N / BM; nwg = nM * nN; G = G_; c = c_; }
    DI bool next(int i, Unit& u) const {
        const long L = (long)i * G + c; if (L >= nwg) return false;
        int wgid = (int)L; { const int q = nwg / NXCD, r = nwg % NXCD, xcd = wgid % NXCD, off = wgid / NXCD; wgid = (xcd < r ? xcd * (q + 1) : r * (q + 1) + (xcd - r) * q) + off; }
        const int nig = WGM * nN, gid = wgid / nig, fm = gid * WGM, gsz = (nM - fm) < WGM ? (nM - fm) : WGM;
        u.pm = fm + ((wgid % nig) % gsz); u.pn = (wgid % nig) / gsz; return true;
    }
    DI void a_ready(const Unit&) const {}
    DI void done(const Unit&) const {}
};
struct ProbeOrder : StaticOrder { DI bool next(int i, Unit& u) const { const bool ok = StaticOrder::next(i, u); u.pm = 0; u.pn = 0; return ok; } };
struct EpiBf16 {
    static constexpr bool PERM = true;
    bf16_t* O; int ldc;
    DI void operator()(const f32x4 (&acc)[2][2][4][2], const Unit& u, int wr, int wc, int fr, int fq) const {
        const int row0 = u.pm * BM + wr * 64 + fr; const int col0 = u.pn * BM + wc * 32 + 8 * fq;
#pragma unroll
        for (int ai = 0; ai < 2; ++ai)
#pragma unroll
            for (int m = 0; m < 4; ++m) { bf16_t* rowp = O + (size_t)(row0 + ai * HALF + m * 16) * ldc + col0;
#pragma unroll
                for (int bj = 0; bj < 2; ++bj) { const f32x4 v0 = acc[ai][bj][m][0], v1 = acc[ai][bj][m][1];
                    u32x4 w; w.x = pk_bf16(v0[0], v0[1]); w.y = pk_bf16(v0[2], v0[3]); w.z = pk_bf16(v1[0], v1[1]); w.w = pk_bf16(v1[2], v1[3]);
                    *(u32x4*)(rowp + bj * HALF) = w; } }
    }
};
struct EpiProj {
    static constexpr bool PERM = true;
    bf16_t* O; int ldc; bf16_t* rvt; bf16_t* fvt; bf16_t* rq; bf16_t* rk; bf16_t* rkt; const float* ct; const float* st;
    DI static void quad_transpose(f32x4& v, int lane) {
        const bool odd = lane & 1, hi = lane & 2;
        { const float s0 = odd ? v[0] : v[1], s1 = odd ? v[2] : v[3];
          const float r0 = __uint_as_float(__builtin_amdgcn_update_dpp(0, (int)__float_as_uint(s0), 0xB1, 0xf, 0xf, false)), r1 = __uint_as_float(__builtin_amdgcn_update_dpp(0, (int)__float_as_uint(s1), 0xB1, 0xf, 0xf, false));
          if (odd) { v[0] = r0; v[2] = r1; } else { v[1] = r0; v[3] = r1; } }
        { const float s0 = hi ? v[0] : v[2], s1 = hi ? v[1] : v[3];
          const float r0 = __uint_as_float(__builtin_amdgcn_update_dpp(0, (int)__float_as_uint(s0), 0x4E, 0xf, 0xf, false)), r1 = __uint_as_float(__builtin_amdgcn_update_dpp(0, (int)__float_as_uint(s1), 0x4E, 0xf, 0xf, false));
          if (hi) { v[0] = r0; v[1] = r1; } else { v[2] = r0; v[3] = r1; } }
    }
    DI void operator()(const f32x4 (&acc)[2][2][4][2], const Unit& u, int wr, int wc, int fr_, int fq_) const {
        const int lid = lane_id(), fr = lid & 15, fq = lid >> 4; (void)fr_; (void)fq_;
        const bool isrv = (u.pn >= 8 && u.pn < 16), isfv = (u.pn >= 40);
        if (u.pn < 8) {
            const bool isk = u.pn >= 4; const float sc = isk ? 0.08838834764831845f : 1.0f;
            bf16_t* dn = isk ? rk : rq;
            const int lane = fq * 16 + fr;
#pragma unroll
            for (int ai = 0; ai < 2; ++ai)
#pragma unroll
                for (int m = 0; m < 4; ++m) { const int t = u.pm * BM + wr * 64 + fr + ai * HALF + m * 16;
                    const int p0 = wc * 32 + 8 * fq;
                    const f32x4 cs = *(const f32x4*)(ct + (size_t)t * 64 + (p0 >> 1)), sn = *(const f32x4*)(st + (size_t)t * 64 + (p0 >> 1));
#pragma unroll
                    for (int bj = 0; bj < 2; ++bj) { const int h = (u.pn & 3) * 2 + bj;
                        const f32x4 v0 = acc[ai][bj][m][0], v1 = acc[ai][bj][m][1];
                        f32x4 o0 = {(v0[0] * cs[0] - v0[1] * sn[0]) * sc, (v0[0] * sn[0] + v0[1] * cs[0]) * sc, (v0[2] * cs[1] - v0[3] * sn[1]) * sc, (v0[2] * sn[1] + v0[3] * cs[1]) * sc};
                        f32x4 o1 = {(v1[0] * cs[2] - v1[1] * sn[2]) * sc, (v1[0] * sn[2] + v1[1] * cs[2]) * sc, (v1[2] * cs[3] - v1[3] * sn[3]) * sc, (v1[2] * sn[3] + v1[3] * cs[3]) * sc};
                        u32x4 w; w.x = pk_bf16(o0[0], o0[1]); w.y = pk_bf16(o0[2], o0[3]); w.z = pk_bf16(o1[0], o1[1]); w.w = pk_bf16(o1[2], o1[3]);
                        *(u32x4*)(dn + (size_t)t * 1024 + h * 128 + p0) = w;
                        if (isk) {
                            const float lg2 = log1pf(-exp2f(-5.f - (float)h)) * LOG2E;
                            const int tq = t & ~3;
                            const float d0 = exp2f((float)(127 - (tq & 127)) * lg2), d1 = exp2f((float)(126 - (tq & 127)) * lg2), d2 = exp2f((float)(125 - (tq & 127)) * lg2), d3 = exp2f((float)(124 - (tq & 127)) * lg2);
                            quad_transpose(o0, lane); quad_transpose(o1, lane);
                            bf16_t* kt = rkt + (size_t)(h * 128 + p0 + (fr & 3)) * T + tq;
                            *(u32x2*)kt = (u32x2){pk_bf16(o0[0] * d0, o0[1] * d1), pk_bf16(o0[2] * d2, o0[3] * d3)};
                            *(u32x2*)(kt + (size_t)4 * T) = (u32x2){pk_bf16(o1[0] * d0, o1[1] * d1), pk_bf16(o1[2] * d2, o1[3] * d3)};
                        } }
                    __builtin_amdgcn_sched_barrier(0); }
        } else if (!(isrv || isfv)) {
            const int row0 = u.pm * BM + wr * 64 + fr; const int col0 = u.pn * BM + wc * 32 + 8 * fq;
#pragma unroll
            for (int ai = 0; ai < 2; ++ai)
#pragma unroll
                for (int m = 0; m < 4; ++m) { bf16_t* rowp = O + (size_t)(row0 + ai * HALF + m * 16) * ldc + col0;
#pragma unroll
                    for (int bj = 0; bj < 2; ++bj) { const f32x4 v0 = acc[ai][bj][m][0], v1 = acc[ai][bj][m][1];
                        u32x4 w; w.x = pk_bf16(v0[0], v0[1]); w.y = pk_bf16(v0[2], v0[3]); w.z = pk_bf16(v1[0], v1[1]); w.w = pk_bf16(v1[2], v1[3]);
                        *(u32x4*)(rowp + bj * HALF) = w; } }
        } else {
            bf16_t* vt = isrv ? rvt + (size_t)(u.pn - 8) * BM * T : fvt + (size_t)(u.pn - 40) * BM * T;
            const int lane = fq * 16 + fr;
            const int rowq = u.pm * BM + wr * 64 + (fr & ~3);
            const int colq = wc * 32 + 8 * fq + (fr & 3);
#pragma unroll
            for (int ai = 0; ai < 2; ++ai)
#pragma unroll
                for (int m = 0; m < 4; ++m)
#pragma unroll
                    for (int bj = 0; bj < 2; ++bj)
#pragma unroll
                        for (int n = 0; n < 2; ++n) { f32x4 v = acc[ai][bj][m][n]; quad_transpose(v, lane);
                            *(u32x2*)(vt + (size_t)(colq + bj * HALF + 4 * n) * T + rowq + ai * HALF + m * 16) = (u32x2){pk_bf16(v[0], v[1]), pk_bf16(v[2], v[3])}; }
        }
    }
};
struct EpiResGate {
    static constexpr bool PERM = false;
    bf16_t* C; const float* res; const float* gate; int ldc;
    DI void operator()(const f32x4 (&acc)[2][2][4][2], const Unit& u, int wr, int wc, int fr, int fq) const {
        const int row0 = u.pm * BM + wr * 64 + fr, col0 = u.pn * BM + wc * 32 + 4 * fq;
        f32x4 gv[2][2];
#pragma unroll
        for (int bj = 0; bj < 2; ++bj)
#pragma unroll
            for (int n = 0; n < 2; ++n) gv[bj][n] = *(const f32x4*)(gate + col0 + bj * HALF + n * 16);
#pragma unroll
        for (int ai = 0; ai < 2; ++ai)
#pragma unroll
            for (int m = 0; m < 4; ++m) { const size_t ro = (size_t)(row0 + ai * HALF + m * 16) * ldc + col0;
#pragma unroll
                for (int bj = 0; bj < 2; ++bj)
#pragma unroll
                    for (int n = 0; n < 2; ++n) { const f32x4 x = *(const f32x4*)(res + ro + bj * HALF + n * 16); const f32x4 y = x + gv[bj][n] * acc[ai][bj][m][n];
                        *(u32x2*)(C + ro + bj * HALF + n * 16) = (u32x2){pk_bf16(y[0], y[1]), pk_bf16(y[2], y[3])}; } }
    }
};

template <class Epi, class Sched>
DI void gemm_phase(int wid_in, LAS unsigned char* lds, const Gemm g, const Sched& S, const Epi& E) {
    const int wid = wid_in, lane = lane_id(), tid = wid * 64 + lane, wr = wid >> 2, wc = wid & 3, fr = lane & 15, fq = lane >> 4;
    const int K = g.K, nt = K / BK;
    unsigned voffA[2], voffB[2];
#pragma unroll
    for (int i = 0; i < 2; ++i) { int R, C; stage_rc(tid * 16 + i * 8192, R, C); const int Rb = Epi::PERM ? ((R & ~31) + perm32(R & 31)) : R;
        voffA[i] = (unsigned)(R * g.ld + C) * 2u; voffB[i] = (unsigned)(Rb * g.ld + C) * 2u; }
    const size_t kstep = (size_t)(BK * 2);
    const size_t hstep = (size_t)HALF * g.ld * 2;
    const size_t tstep = 2 * hstep;
    const unsigned ldsw = (unsigned)wid * 1024u;
    const int aoff = lds_byte(wr * 64 + fr, fq * 8), boff = lds_byte(wc * 32 + fr, fq * 8);
#define PG8_SA(b, h) (((b) * 2 + (h)) * HTB)
#define PG8_SB(b, h) ((4 + (b) * 2 + (h)) * HTB)
#define PG8_STAGE(bufoff, gbase, voff) do { _Pragma("unroll") for (int _i = 0; _i < 2; ++_i) \
        __builtin_amdgcn_global_load_lds((const unsigned*)((const char*)(gbase) + (voff)[_i]), (LAS unsigned*)(lds + (bufoff) + ldsw + _i * 8192), 16, 0, 0); } while (0)
#define PG8_LDA(dst, b, h) do { _Pragma("unroll") for (int m = 0; m < 4; ++m) _Pragma("unroll") for (int k = 0; k < 2; ++k) dst[m][k] = *(const LAS bf16x8*)(lds + PG8_SA(b, h) + aoff + m * 2048 + k * 1024); } while (0)
#define PG8_LDB(dst, b, h) do { _Pragma("unroll") for (int n = 0; n < 2; ++n) _Pragma("unroll") for (int k = 0; k < 2; ++k) dst[n][k] = *(const LAS bf16x8*)(lds + PG8_SB(b, h) + boff + n * 2048 + k * 1024); } while (0)
#define PG8_MMA(ai, bj, At, Bt) do { __builtin_amdgcn_s_setprio(1); _Pragma("unroll") for (int m = 0; m < 4; ++m) _Pragma("unroll") for (int n = 0; n < 2; ++n) _Pragma("unroll") for (int k = 0; k < 2; ++k) \
        acc[ai][bj][m][n] = __builtin_amdgcn_mfma_f32_16x16x32_bf16(Bt[n][k], At[m][k], acc[ai][bj][m][n], 0, 0, 0); __builtin_amdgcn_s_setprio(0); } while (0)
#define PG8_WAIT_V(n) asm volatile("s_waitcnt vmcnt(" #n ")" ::: "memory")
#define PG8_WAIT_L(n) asm volatile("s_waitcnt lgkmcnt(" #n ")" ::: "memory")
#define PG8_BAR __builtin_amdgcn_s_barrier()
#define PG8_SCHED __builtin_amdgcn_sched_barrier(0)
    Unit cur, nxt; int ui = 0;
    if (!S.next(0, cur)) return;
    f32x4 acc[2][2][4][2];
#pragma unroll
    for (int a = 0; a < 2; ++a)
#pragma unroll
        for (int b = 0; b < 2; ++b)
#pragma unroll
            for (int m = 0; m < 4; ++m)
#pragma unroll
                for (int n = 0; n < 2; ++n) acc[a][b][m][n] = (f32x4){0.f, 0.f, 0.f, 0.f};
    bf16x8 At[4][2], B0[2][2], B1[2][2];
    const char* cA = (const char*)g.A + (size_t)cur.pm * tstep; const char* cB = (const char*)g.Bt + (size_t)cur.pn * tstep;
    S.a_ready(cur);
    PG8_STAGE(PG8_SB(0, 0), cB, voffB); PG8_STAGE(PG8_SA(0, 0), cA, voffA); PG8_STAGE(PG8_SB(0, 1), cB + hstep, voffB); PG8_STAGE(PG8_SA(0, 1), cA + hstep, voffA);
    if (wr == 1) PG8_BAR;
    PG8_WAIT_V(4); PG8_BAR;
    PG8_STAGE(PG8_SB(1, 0), cB + kstep, voffB); PG8_STAGE(PG8_SA(1, 0), cA + kstep, voffA); PG8_STAGE(PG8_SB(1, 1), cB + hstep + kstep, voffB);
    PG8_WAIT_V(6); PG8_BAR;
    for (;;) {
        const bool has_next = S.next(ui + 1, nxt);
        const char* nA = has_next ? (const char*)g.A + (size_t)nxt.pm * tstep : cA; const char* nB = has_next ? (const char*)g.Bt + (size_t)nxt.pn * tstep : cB;
        for (int t = 0; t < nt; t += 2) {
            const bool last = (t == nt - 2);
            const char* a1 = cA + (size_t)(t + 1) * kstep;
            const char* a2 = last ? nA : cA + (size_t)(t + 2) * kstep; const char* b2 = last ? nB : cB + (size_t)(t + 2) * kstep;
            const char* a3 = a2 + kstep; const char* b3 = b2 + kstep;
            if (last && has_next) S.a_ready(nxt);
            PG8_LDB(B0, 0, 0); PG8_SCHED; PG8_LDA(At, 0, 0); PG8_STAGE(PG8_SA(1, 1), a1 + hstep, voffA);
            PG8_WAIT_L(8); PG8_BAR; PG8_WAIT_L(0); PG8_MMA(0, 0, At, B0); PG8_BAR; PG8_SCHED;
            PG8_LDB(B1, 0, 1); PG8_STAGE(PG8_SB(0, 0), b2, voffB);
            PG8_BAR; PG8_WAIT_L(0); PG8_MMA(0, 1, At, B1); PG8_BAR;
            PG8_LDA(At, 0, 1); PG8_STAGE(PG8_SA(0, 0), a2, voffA);
            PG8_BAR; PG8_WAIT_L(0); PG8_MMA(1, 0, At, B0); PG8_BAR; PG8_SCHED;
            PG8_STAGE(PG8_SB(0, 1), b2 + hstep, voffB);
            PG8_WAIT_V(6); PG8_BAR; PG8_MMA(1, 1, At, B1); PG8_BAR;
            PG8_LDB(B0, 1, 0); PG8_SCHED; PG8_LDA(At, 1, 0); PG8_STAGE(PG8_SA(0, 1), a2 + hstep, voffA);
            PG8_WAIT_L(8); PG8_BAR; PG8_WAIT_L(0); PG8_MMA(0, 0, At, B0); PG8_BAR; PG8_SCHED;
            PG8_LDB(B1, 1, 1); PG8_STAGE(PG8_SB(1, 0), b3, voffB);
            PG8_BAR; PG8_WAIT_L(0); PG8_MMA(0, 1, At, B1); PG8_BAR;
            PG8_LDA(At, 1, 1); PG8_STAGE(PG8_SA(1, 0), a3, voffA);
            PG8_BAR; PG8_WAIT_L(0); PG8_MMA(1, 0, At, B0); PG8_BAR; PG8_SCHED;
            PG8_STAGE(PG8_SB(1, 1), b3 + hstep, voffB);
            PG8_WAIT_V(6); PG8_BAR; PG8_MMA(1, 1, At, B1); PG8_BAR;
        }
        E(acc, cur, wr, wc, fr, fq); S.done(cur);
        if (!has_next) break;
#pragma unroll
        for (int a = 0; a < 2; ++a)
#pragma unroll
            for (int b = 0; b < 2; ++b)
#pragma unroll
                for (int m = 0; m < 4; ++m)
#pragma unroll
                    for (int n = 0; n < 2; ++n) acc[a][b][m][n] = (f32x4){0.f, 0.f, 0.f, 0.f};
        cur = nxt; cA = nA; cB = nB; ++ui;
    }
    PG8_WAIT_V(0);
    if (wr == 0) PG8_BAR;
    PG8_BAR;
#undef PG8_SA
#undef PG8_SB
#undef PG8_STAGE
#undef PG8_LDA
#undef PG8_LDB
#undef PG8_MMA
#undef PG8_WAIT_V
#undef PG8_WAIT_L
#undef PG8_BAR
#undef PG8_SCHED
}
}

struct Args {
    const float* in[17];
    float* out;
    unsigned char* ws;
    int ph_lo, ph_hi;
    int wid, pad;
};
enum { I_X = 0, I_C, I_POS, I_WADA, I_BADA, I_N1G, I_WIN, I_BF, I_GNG, I_FNG, I_WOUT, I_N2G, I_WPQ, I_SK, I_U, I_V, I_FG };

DI void p0_mod(const Args& a, LAS unsigned char* lds) {
    const int tid = a.wid * 64 + lane_id();
    const float* c = a.in[I_C]; const float* w = a.in[I_WADA]; const float* bb = a.in[I_BADA];
    float* mod = (float*)(a.ws + WS_MOD);
    LAS float* red = (LAS float*)lds;
    for (int s = blockIdx.x; s < 256; s += gridDim.x) {
        const int cq = tid % 24, rg = tid / 24;
        f32x4 acc = {0.f, 0.f, 0.f, 0.f};
        if (tid < 504) {
            const float* wp = w + (size_t)rg * 24576 + s * 96 + cq * 4;
#pragma unroll 8
            for (int r = rg; r < 4096; r += 21) { const float sv = silu_f(c[r]); const f32x4 wv = *(const f32x4*)wp; acc += sv * wv; wp += (size_t)21 * 24576; }
            *(LAS f32x4*)(red + rg * 96 + cq * 4) = acc;
        }
        __syncthreads();
        if (tid < 96) { float sum = bb[s * 96 + tid];
            for (int r = 0; r < 21; ++r) sum += red[r * 96 + tid];
            mod[s * 96 + tid] = sum; }
        __syncthreads();
    }
}
DI void transpose_f32_to_bf16(const Args& a, const float* src, int K, int N, bf16_t* dst, LAS unsigned char* lds, int start, int qkperm = 0) {
    const int tid = a.wid * 64 + lane_id(); LAS float* tile = (LAS float*)lds;
    const int ntk = K / 64, ntn = (N + 63) / 64, ntiles = ntk * ntn;
    for (int ti = (blockIdx.x + start) % gridDim.x; ti < ntiles; ti += gridDim.x) {
        const int tk = ti % ntk, tn = ti / ntk; const int k0 = tk * 64, n0 = tn * 64;
#pragma unroll
        for (int u = 0; u < 2; ++u) { const int kr = (tid >> 4) + 32 * u, nc = (tid & 15) * 4;
            f32x4 v = {0.f, 0.f, 0.f, 0.f};
            if (n0 + nc < N) v = *(const f32x4*)(src + (size_t)(k0 + kr) * N + n0 + nc);
            tile[kr * 65 + nc] = v[0]; tile[kr * 65 + nc + 1] = v[1]; tile[kr * 65 + nc + 2] = v[2]; tile[kr * 65 + nc + 3] = v[3]; }
        __syncthreads();
        { const int n = tid >> 3, kc = (tid & 7) * 8;
          if (n0 + n < N) { float f[8];
#pragma unroll
              for (int j = 0; j < 8; ++j) f[j] = tile[(kc + j) * 65 + n];
              u32x4 w = {pk_bf16(f[0], f[1]), pk_bf16(f[2], f[3]), pk_bf16(f[4], f[5]), pk_bf16(f[6], f[7])};
              int nd = n0 + n; if (nd < qkperm) nd = (nd & ~127) | (((nd & 63) << 1) | ((nd >> 6) & 1));
              *(u32x4*)(dst + (size_t)nd * LDK + k0 + kc) = w; } }
        __syncthreads();
    }
}
DI void convert_f32_to_bf16(const Args& a, const float* src, bf16_t* dst, size_t n) {
    const size_t stride = (size_t)gridDim.x * NTHREADS * 8; const int tid = a.wid * 64 + lane_id();
    for (size_t i = ((size_t)blockIdx.x * NTHREADS + tid) * 8; i < n; i += stride) {
        const f32x4 v0 = *(const f32x4*)(src + i), v1 = *(const f32x4*)(src + i + 4);
        u32x4 w = {pk_bf16(v0[0], v0[1]), pk_bf16(v0[2], v0[3]), pk_bf16(v1[0], v1[1]), pk_bf16(v1[2], v1[3])};
        *(u32x4*)(dst + i) = w;
    }
}
template <int ULAYOUT> DI void quant_rows_i4(const Args& a, const float* src, unsigned char* dst, float* scale) {
    const int wid = a.wid, lane = lane_id(), stride = gridDim.x * 8;
    int row = blockIdx.x * 8 + wid;
    f32x4 nx[16];
    { const float* xr = src + (size_t)(row < 16384 ? row : 16383) * 4096;
#pragma unroll
      for (int c = 0; c < 16; ++c) nx[c] = *(const f32x4*)(xr + c * 256 + lane * 4); }
#pragma unroll 1
    for (; row < 16384; row += stride) {
        f32x4 v[16]; float mx = 0.f;
#pragma unroll
        for (int c = 0; c < 16; ++c) { v[c] = nx[c]; mx = fmaxf(fmaxf(mx, fmaxf(fabsf(v[c][0]), fabsf(v[c][1]))), fmaxf(fabsf(v[c][2]), fabsf(v[c][3]))); }
        { const int rn = row + stride < 16384 ? row + stride : 16383; const float* xr = src + (size_t)rn * 4096;
#pragma unroll
          for (int c = 0; c < 16; ++c) nx[c] = *(const f32x4*)(xr + c * 256 + lane * 4); }
        __builtin_amdgcn_sched_barrier(0);
#pragma unroll
        for (int m = 32; m >= 1; m >>= 1) mx = fmaxf(mx, __shfl_xor(mx, m));
        float bestr = 1.f, beste = 3.0e38f;
#pragma unroll 1
        for (int ci = 0; ci < 6; ++ci) {
            const float r = 1.f - 0.09f * (float)ci, sc = mx * r * (1.f / 7.f), isc = sc > 0.f ? 1.f / sc : 0.f;
            float e = 0.f;
#pragma unroll
            for (int c = 0; c < 8; ++c) { const float x = v[2 * c][c & 3]; const float t = __builtin_amdgcn_fmed3f(x * isc, -7.f, 7.f); const float q = (t + 12582912.f) - 12582912.f; const float d = x - q * sc; e = fmaf(d, d, e); }
#pragma unroll
            for (int m = 32; m >= 1; m >>= 1) e += __shfl_xor(e, m);
            if (e < beste) { beste = e; bestr = r; }
        }
        mx *= bestr;
        const float inv = mx > 0.f ? 7.f / mx : 0.f;
        unsigned qk[16];
#pragma unroll
        for (int c = 0; c < 16; ++c) {
            const unsigned u0 = __float_as_uint(__builtin_amdgcn_fmed3f(v[c][0] * inv, -7.f, 7.f) + 12582920.f), u1 = __float_as_uint(__builtin_amdgcn_fmed3f(v[c][1] * inv, -7.f, 7.f) + 12582920.f);
            const unsigned u2 = __float_as_uint(__builtin_amdgcn_fmed3f(v[c][2] * inv, -7.f, 7.f) + 12582920.f), u3 = __float_as_uint(__builtin_amdgcn_fmed3f(v[c][3] * inv, -7.f, 7.f) + 12582920.f);
            const unsigned p01 = __builtin_amdgcn_perm(u1, u0, 0x0c0c0400u), p23 = __builtin_amdgcn_perm(u3, u2, 0x0c0c0400u);
            const unsigned pk = (p01 | (p23 << 16)) & 0x0F0F0F0Fu;
            if (ULAYOUT) qk[c] = pk;
            else { const unsigned other = __shfl_xor(pk, 32);
                if (lane < 32) *(unsigned*)(dst + (size_t)c * (16384 * 128) + (size_t)row * 128 + lane * 4) = pk | ((other ^ 0x08080808u) << 4); } }
        if (ULAYOUT) {
#pragma unroll
            for (int c = 0; c < 8; ++c) { const unsigned lo = qk[c] ^ 0x08080808u, hi = qk[c + 8] ^ 0x08080808u;
                *(unsigned*)(dst + (size_t)row * 2048 + c * 256 + lane * 4) = lo | (hi << 4); }
        }
        if (lane == 0) scale[row] = mx * (1.f / 7.f);
    }
}
DI void quant_rows_i8(const Args& a, const float* src, unsigned char* dst, float* scale, int bias, int slicemajor) {
    const int wid = a.wid, lane = lane_id(), tid = wid * 64 + lane;
    for (int row = blockIdx.x * 8 + wid; row < 16384; row += gridDim.x * 8) {
        const float* xr = src + (size_t)row * 4096;
        f32x4 v[16]; float mx = 0.f;
#pragma unroll
        for (int c = 0; c < 16; ++c) { v[c] = *(const f32x4*)(xr + c * 256 + lane * 4); mx = fmaxf(mx, fmaxf(fmaxf(fabsf(v[c][0]), fabsf(v[c][1])), fmaxf(fabsf(v[c][2]), fabsf(v[c][3])))); }
#pragma unroll
        for (int m = 32; m >= 1; m >>= 1) mx = fmaxf(mx, __shfl_xor(mx, m));
        const float inv = mx > 0.f ? 127.f / mx : 0.f;
        unsigned* dr = (unsigned*)(dst + (size_t)row * 4096);
#pragma unroll
        for (int c = 0; c < 16; ++c) {
            const int q0 = (int)rintf(v[c][0] * inv) + bias, q1 = (int)rintf(v[c][1] * inv) + bias, q2 = (int)rintf(v[c][2] * inv) + bias, q3 = (int)rintf(v[c][3] * inv) + bias;
            const unsigned pk = (unsigned)(q0 & 255) | ((unsigned)(q1 & 255) << 8) | ((unsigned)(q2 & 255) << 16) | ((unsigned)(q3 & 255) << 24);
            if (slicemajor) *(unsigned*)(dst + (size_t)(2 * c + (lane >> 5)) * (16384 * 128) + (size_t)row * 128 + (lane & 31) * 4) = pk;
            else dr[c * 64 + lane] = pk; }
        if (lane == 0) scale[row] = mx * (1.f / 127.f);
    }
}
DI void phase_prologue(const Args& a, LAS unsigned char* lds) {
    p0_mod(a, lds);
    { const int* pos = (const int*)a.in[I_POS]; float* ct = (float*)(a.ws + WS_COS); float* st = (float*)(a.ws + WS_SIN);
      for (int i = blockIdx.x * NTHREADS + a.wid * 64 + lane_id(); i < T * 64; i += gridDim.x * NTHREADS) {
          const int t = i >> 6, f = i & 63;
          const double inv = exp(-(double)f * (9.210340371976184 / 64.0));
          const double ang = (double)pos[t] * inv;
          ct[i] = (float)cos(ang); st[i] = (float)sin(ang); } }
    transpose_f32_to_bf16(a, a.in[I_WIN], 4096, INW, (bf16_t*)(a.ws + WS_WIN), lds, 0, 2048);
    transpose_f32_to_bf16(a, a.in[I_WOUT], 4096, 4096, (bf16_t*)(a.ws + WS_WOUT), lds, 64);
    transpose_f32_to_bf16(a, a.in[I_WPQ], 4096, 2048, (bf16_t*)(a.ws + WS_WPQ), lds, 64);
    convert_f32_to_bf16(a, a.in[I_SK], (bf16_t*)(a.ws + WS_SKB), (size_t)8 * 2 * 128 * 128);
    quant_rows_i4<1>(a, a.in[I_U], a.ws + WS_UB, (float*)(a.ws + WS_SU));
    quant_rows_i4<0>(a, a.in[I_V], a.ws + WS_VB, (float*)(a.ws + WS_SV));
}

DI void phase_ff(const Args& a, LAS unsigned char* lds) {
    const int wid = a.wid, lane = lane_id(), r16 = lane & 15, kg = lane >> 4;
    const bf16_t* h1 = (const bf16_t*)(a.ws + WS_H1); const bf16_t* wf = (const bf16_t*)(a.ws + WS_WIN) + (size_t)NPAD * LDK;
    float* ffo = (float*)(a.ws + WS_FF);
    LAS float* red = (LAS float*)lds;
    for (int it = blockIdx.x; it < T / 64; it += gridDim.x) {
        const int sub = wid & 3, kh = wid >> 2;
        const bf16_t* ap = h1 + (size_t)(it * 64 + sub * 16 + r16) * LDK + kh * 2048 + kg * 8;
        const bf16_t* bp = wf + (size_t)r16 * LDK + kh * 2048 + kg * 8;
        f32x4 acc = {0.f, 0.f, 0.f, 0.f};
#pragma unroll 8
        for (int s = 0; s < 64; ++s) acc = __builtin_amdgcn_mfma_f32_16x16x32_bf16(*(const bf16x8*)(ap + s * 32), *(const bf16x8*)(bp + s * 32), acc, 0, 0, 0);
        if (kh == 1) {
#pragma unroll
            for (int i = 0; i < 4; ++i) red[(sub * 16 + 4 * kg + i) * 16 + r16] = acc[i]; }
        __syncthreads();
        if (kh == 0) {
#pragma unroll
            for (int i = 0; i < 4; ++i) ffo[(size_t)(it * 64 + sub * 16 + 4 * kg + i) * 16 + r16] = acc[i] + red[(sub * 16 + 4 * kg + i) * 16 + r16]; }
        __syncthreads();
    }
}

DI void phase_norm_mod_bf(const Args& a, const bf16_t* x, const float* g, const float* shift, const float* scale, bf16_t* dst, LAS unsigned char* lds) {
    const int wid = a.wid, lane = lane_id(), tid = wid * 64 + lane;
    LAS float* A1 = (LAS float*)lds; LAS float* B1 = A1 + 4096;
    for (int i = tid; i < 4096; i += NTHREADS) { A1[i] = g[i] * (1.f + scale[i]); B1[i] = shift[i]; }
    __syncthreads();
    for (int row = blockIdx.x * 8 + wid; row < T; row += gridDim.x * 8) {
        const bf16_t* xr = x + (size_t)row * D;
        u32x4 v[8]; float ss = 0.f;
#pragma unroll
        for (int c = 0; c < 8; ++c) { v[c] = *(const u32x4*)(xr + c * 512 + lane * 8);
#pragma unroll
            for (int w = 0; w < 4; ++w) { const float lo = bf_lo(v[c][w]), hi = bf_hi(v[c][w]); ss += lo * lo + hi * hi; } }
        ss = wave_sum(ss);
        const float rs = rsqrtf(ss * (1.f / 4096.f) + EPS);
        bf16_t* dr = dst + (size_t)row * LDK;
#pragma unroll
        for (int c = 0; c < 8; ++c) { const int col = c * 512 + lane * 8;
            const f32x4 a0 = *(const LAS f32x4*)(A1 + col), a1 = *(const LAS f32x4*)(A1 + col + 4), b0 = *(const LAS f32x4*)(B1 + col), b1 = *(const LAS f32x4*)(B1 + col + 4);
            u32x4 w;
            w[0] = pk_bf16(bf_lo(v[c][0]) * rs * a0[0] + b0[0], bf_hi(v[c][0]) * rs * a0[1] + b0[1]); w[1] = pk_bf16(bf_lo(v[c][1]) * rs * a0[2] + b0[2], bf_hi(v[c][1]) * rs * a0[3] + b0[3]);
            w[2] = pk_bf16(bf_lo(v[c][2]) * rs * a1[0] + b1[0], bf_hi(v[c][2]) * rs * a1[1] + b1[1]); w[3] = pk_bf16(bf_lo(v[c][3]) * rs * a1[2] + b1[2], bf_hi(v[c][3]) * rs * a1[3] + b1[3]);
            *(u32x4*)(dr + col) = w; }
    }
    __syncthreads();
}
DI void phase_norm_mod(const Args& a, const float* x, const float* g, const float* shift, const float* scale, bf16_t* dst, LAS unsigned char* lds) {
    const int wid = a.wid, lane = lane_id(), tid = wid * 64 + lane;
    LAS float* A1 = (LAS float*)lds; LAS float* B1 = A1 + 4096;
    for (int i = tid; i < 4096; i += NTHREADS) { A1[i] = g[i] * (1.f + scale[i]); B1[i] = shift[i]; }
    __syncthreads();
    for (int row = blockIdx.x * 8 + wid; row < T; row += gridDim.x * 8) {
        const float* xr = x + (size_t)row * D;
        f32x4 v[16]; float ss = 0.f;
#pragma unroll
        for (int c = 0; c < 16; ++c) { v[c] = *(const f32x4*)(xr + c * 256 + lane * 4); ss += v[c][0] * v[c][0] + v[c][1] * v[c][1] + v[c][2] * v[c][2] + v[c][3] * v[c][3]; }
        ss = wave_sum(ss);
        const float rs = rsqrtf(ss * (1.f / 4096.f) + EPS);
        bf16_t* dr = dst + (size_t)row * LDK;
#pragma unroll
        for (int c = 0; c < 16; ++c) { const int col = c * 256 + lane * 4;
            const f32x4 aa = *(const LAS f32x4*)(A1 + col), bb = *(const LAS f32x4*)(B1 + col);
            const f32x4 y = v[c] * rs * aa + bb;
            u32x2 w = {pk_bf16(y[0], y[1]), pk_bf16(y[2], y[3])};
            *(u32x2*)(dr + col) = w; }
    }
    __syncthreads();
}

template <bool IS_K>
DI void rotary_tile(const Args& a, int pt, int h, LAS unsigned char* lds) {
    const int tid = a.wid * 64 + lane_id();
    const bf16_t* proj = (const bf16_t*)(a.ws + WS_PROJ);
    const float* ct = (const float*)(a.ws + WS_COS); const float* st = (const float*)(a.ws + WS_SIN);
    const int pos = tid >> 3, dq = tid & 7; const int t = pt * 64 + pos;
    const bf16_t* src = proj + (size_t)t * NPAD + (IS_K ? C_RK : C_RQ) + h * 128 + dq * 8;
    const u32x4 x1 = *(const u32x4*)src, x2 = *(const u32x4*)(src + 64);
    const f32x4 c0 = *(const f32x4*)(ct + (size_t)t * 64 + dq * 8), c1 = *(const f32x4*)(ct + (size_t)t * 64 + dq * 8 + 4);
    const f32x4 s0 = *(const f32x4*)(st + (size_t)t * 64 + dq * 8), s1 = *(const f32x4*)(st + (size_t)t * 64 + dq * 8 + 4);
    float cs[8] = {c0[0], c0[1], c0[2], c0[3], c1[0], c1[1], c1[2], c1[3]}, sn[8] = {s0[0], s0[1], s0[2], s0[3], s1[0], s1[1], s1[2], s1[3]};
    float o1[8], o2[8];
    const float sc = IS_K ? 0.08838834764831845f : 1.0f;
#pragma unroll
    for (int j = 0; j < 8; ++j) { const unsigned w1 = x1[j >> 1], w2 = x2[j >> 1];
        const float a1 = (j & 1) ? bf_hi(w1) : bf_lo(w1), a2 = (j & 1) ? bf_hi(w2) : bf_lo(w2);
        o1[j] = (a1 * cs[j] - a2 * sn[j]) * sc; o2[j] = (a1 * sn[j] + a2 * cs[j]) * sc; }
    bf16_t* dn = (bf16_t*)(a.ws + (IS_K ? WS_RK : WS_RQ)) + (size_t)t * 1024 + h * 128 + dq * 8;
    *(u32x4*)dn = (u32x4){pk_bf16(o1[0], o1[1]), pk_bf16(o1[2], o1[3]), pk_bf16(o1[4], o1[5]), pk_bf16(o1[6], o1[7])};
    *(u32x4*)(dn + 64) = (u32x4){pk_bf16(o2[0], o2[1]), pk_bf16(o2[2], o2[3]), pk_bf16(o2[4], o2[5]), pk_bf16(o2[6], o2[7])};
    if constexpr (IS_K) {
        LAS bf16_t* tl = (LAS bf16_t*)lds;
        const float lg = log1pf(-exp2f(-5.f - (float)h));
        const float dec = __expf((float)(127 - (t & 127)) * lg);
#pragma unroll
        for (int j = 0; j < 8; ++j) { tl[(dq * 8 + j) * 66 + pos] = f2bf(o1[j] * dec); tl[(64 + dq * 8 + j) * 66 + pos] = f2bf(o2[j] * dec); }
        __syncthreads();
        { const int d = tid >> 2, pc = (tid & 3) * 16;
          LAS const unsigned* rp = (LAS const unsigned*)(tl + d * 66 + pc);
          u32x4 w0 = {rp[0], rp[1], rp[2], rp[3]}, w1 = {rp[4], rp[5], rp[6], rp[7]};
          bf16_t* dt = (bf16_t*)(a.ws + WS_RKT) + (size_t)(h * 128 + d) * T + pt * 64 + pc;
          *(u32x4*)dt = w0; *(u32x4*)(dt + 8) = w1; }
        __syncthreads();
    }
}
DI void transpose_bf16_tile(const Args& a, const bf16_t* proj, int col0, bf16_t* dst, int pt, int ctile, LAS unsigned char* lds) {
    const int tid = a.wid * 64 + lane_id(); LAS bf16_t* tl = (LAS bf16_t*)lds;
    { const int pos = tid >> 3, cc = (tid & 7) * 8;
      const u32x4 v = *(const u32x4*)(proj + (size_t)(pt * 64 + pos) * NPAD + col0 + ctile * 64 + cc);
      LAS unsigned* wp = (LAS unsigned*)(tl + pos * 72 + cc); wp[0] = v[0]; wp[1] = v[1]; wp[2] = v[2]; wp[3] = v[3]; }
    __syncthreads();
    { const int c = tid >> 3, pc = (tid & 7) * 8; unsigned short e[8];
#pragma unroll
      for (int j = 0; j < 8; ++j) e[j] = tl[(pc + j) * 72 + c];
      u32x4 w = {(unsigned)e[0] | ((unsigned)e[1] << 16), (unsigned)e[2] | ((unsigned)e[3] << 16), (unsigned)e[4] | ((unsigned)e[5] << 16), (unsigned)e[6] | ((unsigned)e[7] << 16)};
      *(u32x4*)(dst + (size_t)(ctile * 64 + c) * T + pt * 64 + pc) = w; }
    __syncthreads();
}
DI void cumsum_head(const Args& a, int h, LAS unsigned char* lds) {
    const int tid = a.wid * 64 + lane_id();
    const bf16_t* proj = (const bf16_t*)(a.ws + WS_PROJ);
    float* cum = (float*)(a.ws + WS_CUM) + (size_t)h * T; const float* ffl = (const float*)(a.ws + WS_FF);
    const float bf = a.in[I_BF][h];
    LAS double* part = (LAS double*)lds;
    float lf[32];
#pragma unroll
    for (int j = 0; j < 32; ++j) { const float f = ffl[(size_t)(tid * 32 + j) * 16 + h] + bf;
        lf[j] = fminf(f, 0.f) - log1pf(__expf(-fabsf(f))); }
    double s = 0.0;
#pragma unroll
    for (int j = 0; j < 32; ++j) s += (double)lf[j];
    part[tid] = s;
    __syncthreads();
    LAS double* pa = part; LAS double* pb = part + NTHREADS;
#pragma unroll 1
    for (int off = 1; off < NTHREADS; off <<= 1) { const double v = pa[tid] + (tid >= off ? pa[tid - off] : 0.0); pb[tid] = v; __syncthreads(); LAS double* t = pa; pa = pb; pb = t; }
    double run = pa[tid] - s;
#pragma unroll
    for (int j = 0; j < 32; ++j) { run += (double)lf[j]; cum[tid * 32 + j] = (float)run; }
    __syncthreads();
}
DI void knorm_item(const Args& a, int item, LAS unsigned char* lds) {
    const int tid = a.wid * 64 + lane_id();
    const bf16_t* proj = (const bf16_t*)(a.ws + WS_PROJ);
    LAS unsigned* smax = (LAS unsigned*)lds;
    if (tid < 16) smax[tid] = 0u;
    __syncthreads();
    const int pos = item * 32 + (tid >> 4), h = tid & 15;
    const bf16_t* kp = proj + (size_t)pos * NPAD + C_FK + h * 128;
    float n2 = 0.f;
#pragma unroll
    for (int c = 0; c < 16; ++c) { const u32x4 w = *(const u32x4*)(kp + c * 8);
#pragma unroll
        for (int j = 0; j < 4; ++j) { const float lo = bf_lo(w[j]), hi = bf_hi(w[j]); n2 += lo * lo + hi * hi; } }
    n2 = fmaxf(n2, __shfl_xor(n2, 16)); n2 = fmaxf(n2, __shfl_xor(n2, 32));
    if ((tid & 63) < 16) (void)__hip_atomic_fetch_max(smax + h, __float_as_uint(n2), __ATOMIC_RELAXED, __HIP_MEMORY_SCOPE_WORKGROUP);
    __syncthreads();
    if (tid < 16) (void)__hip_atomic_fetch_max((unsigned*)(a.ws + WS_CTL) + CW_KMAX + tid, smax[tid], __ATOMIC_RELAXED, __HIP_MEMORY_SCOPE_AGENT);
    __syncthreads();
}
DI void cumsum_seg(const Args& a, int seg, LAS unsigned char* lds) {
    const int lane = lane_id(), tid = a.wid * 64 + lane;
    const float* ffl = (const float*)(a.ws + WS_FF); float* cum = (float*)(a.ws + WS_CUM);
    double* tot = (double*)(a.ws + WS_CSTOT); unsigned* flag = (unsigned*)(a.ws + WS_CTL) + CW_CSFLAG;
    LAS double* lf = (LAS double*)lds;
    LAS double* red = lf + 1024;
    const int t0 = seg * 64;
    { const int tk = tid >> 3, hp = (tid & 7) * 2;
      const f32x2 f = *(const f32x2*)(ffl + (size_t)(t0 + tk) * 16 + hp);
      const float x0 = f[0] + a.in[I_BF][hp], x1 = f[1] + a.in[I_BF][hp + 1];
      lf[tk * 16 + hp] = (double)(fminf(x0, 0.f) - log1pf(__expf(-fabsf(x0))));
      lf[tk * 16 + hp + 1] = (double)(fminf(x1, 0.f) - log1pf(__expf(-fabsf(x1)))); }
    __syncthreads();
    if (tid < 16) { double run = 0.0;
#pragma unroll 8
        for (int k = 0; k < 64; ++k) { run += lf[k * 16 + tid]; lf[k * 16 + tid] = run; }
        tot[seg * 16 + tid] = run; }
    asm volatile("s_waitcnt vmcnt(0)" ::: "memory");
    __syncthreads();
    if (tid == 0) {
        __builtin_amdgcn_fence(__ATOMIC_RELEASE, "agent");
        asm volatile("s_waitcnt vmcnt(0)" ::: "memory");
        __hip_atomic_store(flag + seg, 1u, __ATOMIC_RELAXED, __HIP_MEMORY_SCOPE_AGENT);
    }
    if (tid < seg) { unsigned sp = 0; while (__hip_atomic_load(flag + tid, __ATOMIC_RELAXED, __HIP_MEMORY_SCOPE_AGENT) == 0u) { __builtin_amdgcn_s_sleep(1); if (++sp > (1u << 24)) break; } }
    __builtin_amdgcn_fence(__ATOMIC_ACQUIRE, "agent");
    asm volatile("s_waitcnt vmcnt(0)" ::: "memory");
    __syncthreads();
    { const int h = tid & 15, part = tid >> 4; double sacc = 0.0;
      for (int sg = part; sg < seg; sg += 32) sacc += __builtin_nontemporal_load(tot + sg * 16 + h);
      red[part * 16 + h] = sacc; }
    __syncthreads();
    { const int h = tid >> 5, tk = tid & 31;
      double off = 0.0;
#pragma unroll 8
      for (int pp = 0; pp < 32; ++pp) off += red[pp * 16 + h];
      cum[(size_t)h * T + t0 + tk] = (float)(off + lf[tk * 16 + h]);
      cum[(size_t)h * T + t0 + tk + 32] = (float)(off + lf[(tk + 32) * 16 + h]); }
    __syncthreads();
}
DI void phase_prep(const Args& a, LAS unsigned char* lds) {
    const bf16_t* proj = (const bf16_t*)(a.ws + WS_PROJ);
    if (gridDim.x >= 256) { if (blockIdx.x < 256) cumsum_seg(a, blockIdx.x, lds); }
    else for (int it = blockIdx.x; it < 16; it += gridDim.x) cumsum_head(a, it, lds);
    for (int it = blockIdx.x; it < 512; it += gridDim.x) knorm_item(a, it, lds);
}

constexpr int RO_S = 4096, RO_K = RO_S + 256 * 272;
DI void phase_ret_kv(const Args& a, LAS unsigned char* lds) {
    const int wid = a.wid, lane = lane_id(), tid = wid * 64 + lane, r = lane & 31, hh = lane >> 5;
    const bf16_t* rvt = (const bf16_t*)(a.ws + WS_RVT); const bf16_t* rkt = (const bf16_t*)(a.ws + WS_RKT);
    float* kv = (float*)(a.ws + WS_KV);
    for (int u = blockIdx.x; u < 1024; u += gridDim.x) {
        const int n = u >> 3, h = u & 7;
#pragma unroll
        for (int it = 0; it < 8; ++it) { const int L = it * 512 + tid, row = L >> 4, pc = L & 15;
            *(LAS u32x4*)(lds + RO_S + row * 272 + pc * 16) = *(const u32x4*)(rvt + (size_t)(h * 256 + row) * T + n * 128 + pc * 8); }
#pragma unroll
        for (int it = 0; it < 4; ++it) { const int L = it * 512 + tid, row = L >> 4, pc = L & 15;
            *(LAS u32x4*)(lds + RO_K + row * 272 + pc * 16) = *(const u32x4*)(rkt + (size_t)(h * 128 + row) * T + n * 128 + pc * 8); }
        __syncthreads();
        bf16x8 af[8];
#pragma unroll
        for (int s = 0; s < 8; ++s) af[s] = *(LAS const bf16x8*)(lds + RO_S + (wid * 32 + r) * 272 + hh * 16 + s * 32);
        f32x16 acc[4];
#pragma unroll
        for (int tn = 0; tn < 4; ++tn) {
#pragma unroll
            for (int i = 0; i < 16; ++i) acc[tn][i] = 0.f;
#pragma unroll
            for (int s = 0; s < 8; ++s) acc[tn] = MFMA32(af[s], *(LAS const bf16x8*)(lds + RO_K + (tn * 32 + r) * 272 + hh * 16 + s * 32), acc[tn]);
        }
        float* op = kv + ((size_t)(n * 8 + h) * 256 + wid * 32) * 128;
#pragma unroll
        for (int tn = 0; tn < 4; ++tn)
#pragma unroll
            for (int i = 0; i < 16; ++i) op[(size_t)crow(i, hh) * 128 + tn * 32 + r] = acc[tn][i];
        __syncthreads();
    }
}
DI void ret_scan_item(const Args& a, int item) {
    float* kv = (float*)(a.ws + WS_KV);
    constexpr int PER = 8 * 256 * 128;
    const int h = item >> 3;
    const float dec = __expf(128.f * log1pf(-exp2f(-5.f - (float)h)));
    const int base = item * 4096 + a.wid * 64 + lane_id();
    float S[8];
#pragma unroll
    for (int e = 0; e < 8; ++e) S[e] = 0.f;
#pragma unroll 1
    for (int n0 = 0; n0 < 128; n0 += 4) {
        float v[4][8];
#pragma unroll
        for (int j = 0; j < 4; ++j)
#pragma unroll
            for (int e = 0; e < 8; ++e) v[j][e] = kv[(size_t)(n0 + j) * PER + base + e * 512];
#pragma unroll
        for (int j = 0; j < 4; ++j)
#pragma unroll
            for (int e = 0; e < 8; ++e) { kv[(size_t)(n0 + j) * PER + base + e * 512] = S[e]; S[e] = S[e] * dec + v[j][e]; }
    }
    asm volatile("s_waitcnt vmcnt(0)" ::: "memory");
    __syncthreads();
    if (a.wid == 0 && lane_id() == 0) {
        __builtin_amdgcn_fence(__ATOMIC_RELEASE, "agent");
        asm volatile("s_waitcnt vmcnt(0)" ::: "memory");
        (void)__hip_atomic_fetch_add((unsigned*)(a.ws + WS_CTL) + CW_SCAN + 64 * h, 1u, __ATOMIC_RELAXED, __HIP_MEMORY_SCOPE_AGENT);
    }
}
DI void ret_scan_wait(const Args& a, int h) {
    if (a.wid == 0 && lane_id() == 0) {
        unsigned* cnt = (unsigned*)(a.ws + WS_CTL) + CW_SCAN + 64 * h; unsigned sp = 0;
        while (__hip_atomic_load(cnt, __ATOMIC_RELAXED, __HIP_MEMORY_SCOPE_AGENT) < 8u) { __builtin_amdgcn_s_sleep(2); if (++sp > (1u << 26)) break; }
        __builtin_amdgcn_fence(__ATOMIC_ACQUIRE, "agent");
        asm volatile("s_waitcnt vmcnt(0)" ::: "memory");
    }
    __syncthreads();
}

DI void ret_out_unit(const Args& a, int n, int h, LAS unsigned char* lds) {
    const int wid = a.wid, lane = lane_id(), tid = wid * 64 + lane, r = lane & 31, hh = lane >> 5;
    const int qg = wid & 3, eh = wid >> 2;
    const bf16_t* rq = (const bf16_t*)(a.ws + WS_RQ); const bf16_t* rk = (const bf16_t*)(a.ws + WS_RK); const bf16_t* rvt = (const bf16_t*)(a.ws + WS_RVT);
    const float* st = (const float*)(a.ws + WS_KV) + (size_t)(n * 8 + h) * 256 * 128;
    const bf16_t* proj = (const bf16_t*)(a.ws + WS_PROJ);
    bf16_t* y = (bf16_t*)(a.ws + WS_H1);
    const int p0 = n * 128; const int il = qg * 32 + r;
    const float lg2 = log1pf(-exp2f(-5.f - (float)h)) * LOG2E;
#pragma unroll
    for (int it = 0; it < 8; ++it) { const int L = it * 512 + tid, row = L >> 4, dc = L & 15;
        const f32x4 f0 = *(const f32x4*)(st + (size_t)row * 128 + dc * 8), f1 = *(const f32x4*)(st + (size_t)row * 128 + dc * 8 + 4);
        *(LAS bf16x8*)(lds + RO_S + row * 272 + dc * 16) = pack8(f0[0], f0[1], f0[2], f0[3], f1[0], f1[1], f1[2], f1[3]); }
#pragma unroll
    for (int it = 0; it < 4; ++it) { const int L = it * 512 + tid, pos = L >> 4, dc = L & 15;
        *(LAS u32x4*)(lds + RO_K + pos * 272 + dc * 16) = *(const u32x4*)(rk + (size_t)(p0 + pos) * 1024 + h * 128 + dc * 8); }
    bf16x8 qf[8];
    { const bf16_t* qp = rq + (size_t)(p0 + il) * 1024 + h * 128 + hh * 8;
#pragma unroll
      for (int s = 0; s < 8; ++s) qf[s] = *(const bf16x8*)(qp + s * 16); }
    __syncthreads();
    f32x16 O[4];
#pragma unroll
    for (int et = 0; et < 4; ++et) {
#pragma unroll
        for (int i = 0; i < 16; ++i) O[et][i] = 0.f;
        LAS const unsigned char* sp = lds + RO_S + (eh * 128 + et * 32 + r) * 272 + hh * 16;
#pragma unroll
        for (int s = 0; s < 8; ++s) O[et] = MFMA32(*(LAS const bf16x8*)(sp + s * 32), qf[s], O[et]);
    }
    { const float fq = exp2f((float)(il + 1) * lg2);
#pragma unroll
      for (int et = 0; et < 4; ++et)
#pragma unroll
          for (int i = 0; i < 16; ++i) O[et][i] *= fq; }
    __syncthreads();
#pragma unroll
    for (int it = 0; it < 8; ++it) { const int L = it * 512 + tid, row = L >> 4, pc = L & 15;
        *(LAS u32x4*)(lds + RO_S + row * 272 + pc * 16) = *(const u32x4*)(rvt + (size_t)(h * 256 + row) * T + p0 + pc * 8); }
    __syncthreads();
    for (int jt = 0; jt <= qg; ++jt) {
        f32x16 sc;
#pragma unroll
        for (int i = 0; i < 16; ++i) sc[i] = 0.f;
        LAS const unsigned char* kp = lds + RO_K + (jt * 32 + r) * 272 + hh * 16;
#pragma unroll
        for (int s = 0; s < 8; ++s) sc = MFMA32(*(LAS const bf16x8*)(kp + s * 32), qf[s], sc);
        float p[16];
#pragma unroll
        for (int i = 0; i < 16; ++i) { const int dj = il - (jt * 32 + crow(i, hh)); p[i] = dj >= 0 ? sc[i] * exp2f((float)dj * lg2) : 0.f; }
#pragma unroll
        for (int ks = 0; ks < 2; ++ks) {
            const bf16x8 pb = pack8(p[8 * ks], p[8 * ks + 1], p[8 * ks + 2], p[8 * ks + 3], p[8 * ks + 4], p[8 * ks + 5], p[8 * ks + 6], p[8 * ks + 7]);
#pragma unroll
            for (int et = 0; et < 4; ++et) {
                LAS const unsigned char* vp = lds + RO_S + (eh * 128 + et * 32 + r) * 272 + (jt * 32 + ks * 16 + hh * 4) * 2;
                const u32x2 lo = *(LAS const u32x2*)vp, hi = *(LAS const u32x2*)(vp + 16);
                const u32x4 w = {lo[0], lo[1], hi[0], hi[1]};
                O[et] = MFMA32(__builtin_bit_cast(bf16x8, w), pb, O[et]);
            }
        }
    }
    float s1 = 0.f, s2 = 0.f;
#pragma unroll
    for (int et = 0; et < 4; ++et)
#pragma unroll
        for (int i = 0; i < 16; ++i) { s1 += O[et][i]; s2 += O[et][i] * O[et][i]; }
    s1 = swap32_sum(s1); s2 = swap32_sum(s2);
    LAS float* ex = (LAS float*)lds;
    if (hh == 0) { ex[(wid * 32 + r) * 2] = s1; ex[(wid * 32 + r) * 2 + 1] = s2; }
    __syncthreads();
    s1 += ex[((wid ^ 4) * 32 + r) * 2]; s2 += ex[((wid ^ 4) * 32 + r) * 2 + 1];
    const float mu = s1 * (1.f / 256.f); const float var = fmaxf(s2 * (1.f / 256.f) - mu * mu, 0.f); const float rs = rsqrtf(var + EPS);
    const float* gg = a.in[I_GNG] + h * 256 + eh * 128;
    LAS unsigned char* tw = lds + 4096 + wid * (32 * 264);
#pragma unroll
    for (int et = 0; et < 4; ++et)
#pragma unroll
        for (int g4 = 0; g4 < 4; ++g4) { const int e0 = et * 32 + 8 * g4 + 4 * hh; const f32x4 gn = *(const f32x4*)(gg + e0);
            *(LAS u32x2*)(tw + r * 264 + e0 * 2) = (u32x2){pk_bf16((O[et][4 * g4] - mu) * rs * gn[0], (O[et][4 * g4 + 1] - mu) * rs * gn[1]), pk_bf16((O[et][4 * g4 + 2] - mu) * rs * gn[2], (O[et][4 * g4 + 3] - mu) * rs * gn[3])}; }
#pragma unroll
    for (int c = 0; c < 8; ++c) { const int chunk = c * 64 + lane; const int tr = chunk >> 4, ec = (chunk & 15) * 8;
        const int t = p0 + qg * 32 + tr;
        const u32x2 ya = *(LAS const u32x2*)(tw + tr * 264 + ec * 2), yb = *(LAS const u32x2*)(tw + tr * 264 + ec * 2 + 8);
        const u32x4 gw = *(const u32x4*)(proj + (size_t)t * NPAD + C_RG + h * 256 + eh * 128 + ec);
        u32x4 o;
        o[0] = pk_bf16(bf_lo(ya[0]) * silu_f(bf_lo(gw[0])), bf_hi(ya[0]) * silu_f(bf_hi(gw[0]))); o[1] = pk_bf16(bf_lo(ya[1]) * silu_f(bf_lo(gw[1])), bf_hi(ya[1]) * silu_f(bf_hi(gw[1])));
        o[2] = pk_bf16(bf_lo(yb[0]) * silu_f(bf_lo(gw[2])), bf_hi(yb[0]) * silu_f(bf_hi(gw[2]))); o[3] = pk_bf16(bf_lo(yb[1]) * silu_f(bf_lo(gw[3])), bf_hi(yb[1]) * silu_f(bf_hi(gw[3])));
        *(u32x4*)(y + (size_t)t * LDK + h * 256 + eh * 128 + ec) = o; }
    __syncthreads();
}

DI int at_k(int sl) { return sl == 0 ? 0 : sl == 1 ? 16384 : sl == 2 ? 67584 : 83968; }
DI int at_v(int sl) { return sl == 0 ? 32768 : sl == 1 ? 50176 : sl == 2 ? 100352 : 132096; }
DI int at_c(int sl) { return 117760 + sl * 256; }
constexpr int AT_END = 118784;
DI void attn_unit(const Args& a, int h, int qb, LAS unsigned char* lds) {
    const int wid = a.wid, lane = lane_id(), tid = wid * 64 + lane, r = lane & 31, hh = lane >> 5;
    const bf16_t* proj = (const bf16_t*)(a.ws + WS_PROJ); const bf16_t* fvt = (const bf16_t*)(a.ws + WS_FVT) + (size_t)h * 128 * T;
    const float* cum = (const float*)(a.ws + WS_CUM) + (size_t)h * T;
    bf16_t* y = (bf16_t*)(a.ws + WS_H1);
    const int I0 = qb * 256; const int irow = I0 + wid * 32 + r;
    constexpr float C2 = 0.08838834764831845f * LOG2E;
    const float cref = cum[I0];
    const float ci2 = (cum[irow] - cref) * LOG2E;
    bf16x8 qf[8];
    { const bf16_t* qp = proj + (size_t)irow * NPAD + C_FQ + h * 128 + hh * 8;
#pragma unroll
      for (int s = 0; s < 8; ++s) qf[s] = *(const bf16x8*)(qp + s * 16); }
    f32x16 O[4];
#pragma unroll
    for (int et = 0; et < 4; ++et)
#pragma unroll
        for (int i = 0; i < 16; ++i) O[et][i] = 0.f;
    float m = -1e30f, l = 0.f;
    const int nt = qb * 4 + 4;
    float Bi;
    { float q2 = 0.f;
#pragma unroll
      for (int s = 0; s < 8; ++s)
#pragma unroll
          for (int j = 0; j < 8; ++j) { const float x = bf2f((bf16_t)qf[s][j]); q2 += x * x; }
      q2 = swap32_sum(q2);
      const float kmax = sqrtf(__uint_as_float(((const unsigned*)(a.ws + WS_CTL))[CW_KMAX + h]));
      Bi = sqrtf(q2) * kmax * C2 * 1.0001f + ci2; }
    float thresh = 3.0e38f;
    u32x4 kreg[2], vreg[2]; float creg = 0.f;
    const bf16_t* kbase = proj + C_FK + h * 128;
#define AT_LOAD(kt) do { _Pragma("unroll") for (int u_ = 0; u_ < 2; ++u_) { const int c_ = tid + 512 * u_; \
        kreg[u_] = *(const u32x4*)(kbase + (size_t)((kt) * 64 + (c_ >> 4)) * NPAD + (c_ & 15) * 8); \
        vreg[u_] = *(const u32x4*)(fvt + (size_t)(c_ >> 3) * T + (kt) * 64 + (c_ & 7) * 8); } \
        if (tid < 64) creg = (cum[(kt) * 64 + tid] - cref) * LOG2E; } while (0)
#define AT_STORE(KOFF, VOFF, COFF) do { _Pragma("unroll") for (int u_ = 0; u_ < 2; ++u_) { const int c_ = tid + 512 * u_; const int key_ = c_ >> 4; \
        *(LAS u32x4*)(lds + (KOFF) + key_ * 256 + (((c_ & 15) * 16) ^ ((key_ & 7) << 4))) = kreg[u_]; \
        LAS unsigned char* vp_ = lds + (VOFF) + (c_ >> 3) * 136 + (c_ & 7) * 16; \
        *(LAS u32x2*)vp_ = (u32x2){vreg[u_][0], vreg[u_][1]}; *(LAS u32x2*)(vp_ + 8) = (u32x2){vreg[u_][2], vreg[u_][3]}; } \
        if (tid < 64) *(LAS float*)(lds + (COFF) + tid * 4) = creg; } while (0)
    AT_LOAD(nt - 1);
    AT_STORE(at_k(0), at_v(0), at_c(0));
    AT_LOAD(nt - 2);
    AT_STORE(at_k(1), at_v(1), at_c(1));
    __syncthreads();
    for (int it = 0; it < nt; ++it) {
        const int kt = nt - 1 - it;
        const int KO = at_k(it & 3), VO = at_v(it & 3), CO = at_c(it & 3);
        if (it >= 4) { if (*(LAS const float*)(lds + CO + 63 * 4) > thresh) break; }
        if (kt > 1) AT_LOAD(kt - 2);
        const int key0 = kt * 64;
        if (key0 <= I0 + wid * 32 + 31) {
            f32x16 st[2];
#pragma unroll
            for (int th = 0; th < 2; ++th) {
#pragma unroll
                for (int i = 0; i < 16; ++i) st[th][i] = 0.f;
                LAS const unsigned char* kp = lds + KO + (th * 32 + r) * 256;
#pragma unroll
                for (int s = 0; s < 8; ++s) { const bf16x8 kf = *(LAS const bf16x8*)(kp + ((s * 32 + hh * 16) ^ ((r & 7) << 4))); st[th] = MFMA32(kf, qf[s], st[th]); }
            }
            float tv[2][16]; float mx = -__builtin_inff();
            const bool diag = (key0 + 63 > I0 + wid * 32);
            if (diag) {
#pragma unroll
            for (int th = 0; th < 2; ++th)
#pragma unroll
                for (int g4 = 0; g4 < 4; ++g4) { const f32x4 cj = *(LAS const f32x4*)(lds + CO + (th * 32 + 8 * g4 + 4 * hh) * 4);
#pragma unroll
                    for (int q = 0; q < 4; ++q) { const int i = g4 * 4 + q; float tt = fmaf(st[th][i], C2, -cj[q]);
                        const int kj = key0 + th * 32 + 8 * g4 + 4 * hh + q; tt = (kj <= irow) ? tt : -__builtin_inff();
                        tv[th][i] = tt; mx = fmaxf(mx, tt); } }
            } else {
#pragma unroll
            for (int th = 0; th < 2; ++th)
#pragma unroll
                for (int g4 = 0; g4 < 4; ++g4) { const f32x4 cj = *(LAS const f32x4*)(lds + CO + (th * 32 + 8 * g4 + 4 * hh) * 4);
#pragma unroll
                    for (int q = 0; q < 4; ++q) { const int i = g4 * 4 + q; const float tt = fmaf(st[th][i], C2, -cj[q]);
                        tv[th][i] = tt; mx = fmaxf(mx, tt); } }
            }
            asm volatile("" ::: "memory");
            mx = swap32_max(mx) + ci2;
            if (!__all(mx < m - 40.f)) {
            const float mn = fmaxf(m, mx);
            if (!__all(mx <= m)) {
                const float alpha = __builtin_amdgcn_exp2f(m - mn); l *= alpha;
#pragma unroll
                for (int et = 0; et < 4; ++et)
#pragma unroll
                    for (int i = 0; i < 16; ++i) O[et][i] *= alpha;
            }
            m = mn;
            const float off = ci2 - mn; float ps = 0.f;
#pragma unroll
            for (int th = 0; th < 2; ++th)
#pragma unroll
                for (int i = 0; i < 16; ++i) { tv[th][i] = __builtin_amdgcn_exp2f(tv[th][i] + off); ps += tv[th][i]; }
            ps = swap32_sum(ps);
            l += ps;
#pragma unroll
            for (int ks = 0; ks < 4; ++ks) {
                const int th = ks >> 1, b = (ks & 1) * 8;
                const bf16x8 pb = pack8(tv[th][b], tv[th][b + 1], tv[th][b + 2], tv[th][b + 3], tv[th][b + 4], tv[th][b + 5], tv[th][b + 6], tv[th][b + 7]);
#pragma unroll
                for (int et = 0; et < 4; ++et) {
                    LAS const unsigned char* vp = lds + VO + (et * 32 + r) * 136 + (ks * 16 + hh * 4) * 2;
                    const u32x2 lo = *(LAS const u32x2*)vp, hi = *(LAS const u32x2*)(vp + 16);
                    const u32x4 w = {lo[0], lo[1], hi[0], hi[1]};
                    O[et] = MFMA32(__builtin_bit_cast(bf16x8, w), pb, O[et]);
                }
            }
            }
        }
        if (kt > 1) { const int sn = (it + 2) & 3; AT_STORE(at_k(sn), at_v(sn), at_c(sn)); }
        if (it == 3) { float v = Bi - m;
#pragma unroll
            for (int mm = 32; mm >= 1; mm >>= 1) v = fmaxf(v, __shfl_xor(v, mm));
            if (lane == 0) *(LAS float*)(lds + AT_END + wid * 4) = v; }
        if (it & 1) __syncthreads();
        if (it == 3) { float v = *(LAS const float*)(lds + AT_END);
#pragma unroll
            for (int w = 1; w < 8; ++w) v = fmaxf(v, *(LAS const float*)(lds + AT_END + w * 4));
            thresh = v + 40.f; }
    }
#undef AT_LOAD
#undef AT_STORE
    const float il = 1.f / l;
    __syncthreads();
    LAS unsigned char* tw = lds + wid * (32 * 264);
#pragma unroll
    for (int et = 0; et < 4; ++et)
#pragma unroll
        for (int g4 = 0; g4 < 4; ++g4) { const int e0 = et * 32 + 8 * g4 + 4 * hh;
            *(LAS u32x2*)(tw + r * 264 + e0 * 2) = (u32x2){pk_bf16(O[et][4 * g4] * il, O[et][4 * g4 + 1] * il), pk_bf16(O[et][4 * g4 + 2] * il, O[et][4 * g4 + 3] * il)}; }
#pragma unroll
    for (int c = 0; c < 8; ++c) { const int chunk = c * 64 + lane; const int tr = chunk >> 4, ec = (chunk & 15) * 8;
        const u32x2 ya = *(LAS const u32x2*)(tw + tr * 264 + ec * 2), yb = *(LAS const u32x2*)(tw + tr * 264 + ec * 2 + 8);
        *(u32x4*)(y + (size_t)(I0 + wid * 32 + tr) * LDK + 2048 + h * 128 + ec) = (u32x4){ya[0], ya[1], yb[0], yb[1]}; }
}

DI void phase_mixer(const Args& a, LAS unsigned char* lds, int qslot = 0) {
    unsigned* qhead = (unsigned*)(a.ws + WS_CTL) + CW_QUEUE + 64 * qslot;
    LAS unsigned* bc = (LAS unsigned*)(lds + LDS_MISC_OFF);
    for (;;) {
        if (a.wid == 0 && lane_id() == 0) *bc = atomicAdd(qhead, 1u);
        __syncthreads();
        const unsigned it = *bc;
        __syncthreads();
        if (it >= 64u + 2048u) break;
        if (it < 64u) ret_scan_item(a, (int)it);
        else if (it < 64u + 1024u) { const unsigned k = it - 64u; attn_unit(a, (int)(k & 15u), 63 - (int)(k >> 4), lds); }
        else { const unsigned k = it - 64u - 1024u; ret_scan_wait(a, (int)(k & 7u)); ret_out_unit(a, (int)(k >> 3), (int)(k & 7u), lds); }
    }
}

DI void phase_fox_norm(const Args& a) {
    const int wid = a.wid, lane = lane_id(), tid = wid * 64 + lane;
    bf16_t* y = (bf16_t*)(a.ws + WS_H1); const float* g = a.in[I_FNG];
    for (int row = blockIdx.x * 8 + wid; row < T; row += gridDim.x * 8) {
        bf16_t* yr = y + (size_t)row * LDK + 2048;
        u32x4 v[4]; float ss = 0.f;
#pragma unroll
        for (int c = 0; c < 4; ++c) { v[c] = *(const u32x4*)(yr + c * 512 + lane * 8);
#pragma unroll
            for (int j = 0; j < 4; ++j) { const float lo = bf_lo(v[c][j]), hi = bf_hi(v[c][j]); ss += lo * lo + hi * hi; } }
        ss = wave_sum(ss);
        const float rs = rsqrtf(ss * (1.f / 2048.f) + EPS);
#pragma unroll
        for (int c = 0; c < 4; ++c) { const int col = c * 512 + lane * 8; const f32x4 g0 = *(const f32x4*)(g + col), g1 = *(const f32x4*)(g + col + 4);
            u32x4 w = {pk_bf16(bf_lo(v[c][0]) * rs * g0[0], bf_hi(v[c][0]) * rs * g0[1]), pk_bf16(bf_lo(v[c][1]) * rs * g0[2], bf_hi(v[c][1]) * rs * g0[3]),
                       pk_bf16(bf_lo(v[c][2]) * rs * g1[0], bf_hi(v[c][2]) * rs * g1[1]), pk_bf16(bf_lo(v[c][3]) * rs * g1[2], bf_hi(v[c][3]) * rs * g1[3])};
            *(u32x4*)(yr + col) = w; }
    }
}

DI void ce_desc(float& x, float& y) { const float hi = fmaxf(x, y), lo = fminf(x, y); x = hi; y = lo; }
DI void sort16_desc(float (&v)[16]) {
#pragma unroll
    for (int k = 2; k <= 16; k <<= 1)
#pragma unroll
        for (int j = k >> 1; j > 0; j >>= 1)
#pragma unroll
            for (int i = 0; i < 16; ++i) { const int l = i ^ j; if (l > i) { if ((i & k) == 0) ce_desc(v[i], v[l]); else ce_desc(v[l], v[i]); } }
}
DI void merge16_desc(float (&x)[16], const float (&y)[16]) {
#pragma unroll
    for (int i = 0; i < 16; ++i) x[i] = fmaxf(x[i], y[15 - i]);
#pragma unroll
    for (int j = 8; j > 0; j >>= 1)
#pragma unroll
        for (int i = 0; i < 16; ++i) { const int l = i ^ j; if (l > i) ce_desc(x[i], x[l]); }
}
DI float tag_low(float v, unsigned mask, unsigned tag) { return __uint_as_float((__float_as_uint(v) & ~mask) | tag); }

constexpr int PE_EIDX = 0, PE_GATE = 16384, PE_A = 32768, PE_LIST = 49152, PE_SH = LDS_MISC_OFF + 64, PE_PSUM = PE_SH + 256;
constexpr size_t WS_HQ = WS_KV;
constexpr int PEER_SLICE_SHIFT = 10;

DI void peer_route(const Args& a, int t0, int rowbase, LAS unsigned char* lds) {
    const int wid = a.wid, lane = lane_id(), r = lane & 31, hh = lane >> 5;
    const bf16_t* qp = (const bf16_t*)(a.ws + WS_QP); const bf16_t* skb = (const bf16_t*)(a.ws + WS_SKB);
    {
        float top[2][16];
#pragma unroll
        for (int p = 0; p < 2; ++p) {
            bf16x8 qf[8];
            const bf16_t* qr = qp + (size_t)(t0 + r) * 2048 + wid * 256 + p * 128 + hh * 8;
#pragma unroll
            for (int s = 0; s < 8; ++s) qf[s] = *(const bf16x8*)(qr + s * 16);
            float best[16];
#pragma unroll 1
            for (int kt = 0; kt < 4; ++kt) {
                f32x16 sc;
#pragma unroll
                for (int i = 0; i < 16; ++i) sc[i] = 0.f;
                const bf16_t* kr = skb + (size_t)((wid * 2 + p) * 128 + kt * 32 + r) * 128 + hh * 8;
#pragma unroll
                for (int s = 0; s < 8; ++s) sc = MFMA32(*(const bf16x8*)(kr + s * 16), qf[s], sc);
                float g[16];
#pragma unroll
                for (int i = 0; i < 16; ++i) g[i] = tag_low(sc[i], 127u, (unsigned)(kt * 32 + crow(i, hh)));
                sort16_desc(g);
                if (kt == 0) {
#pragma unroll
                    for (int i = 0; i < 16; ++i) best[i] = g[i];
                } else merge16_desc(best, g);
            }
            float oth[16];
#pragma unroll
            for (int i = 0; i < 16; ++i) oth[i] = swap32_other(best[i], hh);
            merge16_desc(best, oth);
#pragma unroll
            for (int i = 0; i < 16; ++i) top[p][i] = best[i];
        }
        LAS unsigned* lst = (LAS unsigned*)(lds + PE_LIST) + (wid * 32 + r) * 32;
        if (hh == 0) {
#pragma unroll
            for (int i = 0; i < 16; ++i) { lst[i] = __float_as_uint(top[0][i]) & 127u; lst[16 + i] = __float_as_uint(top[1][i]) & 127u; }
        }
        float cg[4][16]; int cnt = 0;
#pragma unroll
        for (int i = 0; i < 16; ++i)
#pragma unroll
            for (int j = 0; j < 16; ++j) if ((i + 1) * (j + 1) <= 16) { cg[cnt >> 4][cnt & 15] = tag_low(top[0][i] + top[1][j], 255u, (unsigned)(i * 16 + j)); ++cnt; }
#pragma unroll
        for (int k = 50; k < 64; ++k) cg[k >> 4][k & 15] = -__builtin_inff();
        sort16_desc(cg[0]); sort16_desc(cg[1]); sort16_desc(cg[2]); sort16_desc(cg[3]);
        merge16_desc(cg[0], cg[1]); merge16_desc(cg[2], cg[3]); merge16_desc(cg[0], cg[2]);
        float ex[16], z = 0.f;
#pragma unroll
        for (int k = 0; k < 16; ++k) { ex[k] = __expf(cg[0][k] - cg[0][0]); z += ex[k]; }
        const float iz = 1.f / z;
        asm volatile("s_waitcnt lgkmcnt(0)" ::: "memory");
        LAS int* eo = (LAS int*)(lds + PE_EIDX) + (rowbase + r) * 128 + wid * 16; LAS float* go = (LAS float*)(lds + PE_GATE) + (rowbase + r) * 128 + wid * 16;
#pragma unroll
        for (int k = 0; k < 16; ++k) if ((k >> 3) == hh) { const unsigned code = __float_as_uint(cg[0][k]) & 255u;
            const unsigned i1 = lst[code >> 4], i2 = lst[16 + (code & 15u)];
            eo[k] = (int)(i1 * 128u + i2); go[k] = ex[k] * iz; }
    }
}

DI int reduce4(const int (&d)[4], int lane) {
    const bool b0 = lane & 1, b1 = lane & 2;
    const int t0v = (b0 ? d[1] : d[0]) + __shfl_xor(b0 ? d[0] : d[1], 1);
    const int t1v = (b0 ? d[3] : d[2]) + __shfl_xor(b0 ? d[2] : d[3], 1);
    int tot = (b1 ? t1v : t0v) + __shfl_xor(b1 ? t0v : t1v, 2);
#pragma unroll
    for (int m = 4; m <= 32; m <<= 1) tot += __shfl_xor(tot, m);
    return tot;
}
DI void pu_issue(const unsigned char* uq, LAS const unsigned* lst, int b, unsigned ulane, unsigned (&ew)[4], u32x4 (&r)[4][2]) {
    const u32x4 w = *(LAS const u32x4*)(lst + 4 * b);
#pragma unroll
    for (int i = 0; i < 4; ++i) { ew[i] = (unsigned)__builtin_amdgcn_readfirstlane((int)w[i]);
        const unsigned char* rp = uq + (size_t)(ew[i] & 16383u) * 2048 + ulane * 16u;
        r[i][0] = *(const u32x4*)rp; r[i][1] = *(const u32x4*)(rp + 1024); }
}
DI int pu_dot(const u32x4 (&r)[2], const u32x4 (&h)[4]) {
    int ah = 0, al = 0;
#pragma unroll
    for (int c = 0; c < 2; ++c)
#pragma unroll
        for (int i = 0; i < 4; ++i) { ah = __builtin_amdgcn_sdot8((int)r[c][i], (int)h[c][i], ah, false); al = __builtin_amdgcn_sdot8((int)r[c][i], (int)h[2 + c][i], al, false); }
    return ah * 16 + al;
}
DI void pu_compute(const unsigned (&ew)[4], const u32x4 (&r)[4][2], const u32x4 (&hq)[4][4], LAS int* abase, LAS const unsigned* lst, int b, int lane) {
    int d[4];
#pragma unroll
    for (int i = 0; i < 4; ++i) { const unsigned q = (ew[i] >> 14) & 3u;
        if (q == 0u) d[i] = pu_dot(r[i], hq[0]); else if (q == 1u) d[i] = pu_dot(r[i], hq[1]); else if (q == 2u) d[i] = pu_dot(r[i], hq[2]); else d[i] = pu_dot(r[i], hq[3]); }
    const int tot = reduce4(d, lane);
    const unsigned wl = lst[4 * b + (lane & 3)];
    if (lane < 4) abase[((wl >> 14) & 3u) * 128u + (wl >> 16)] = tot;
}
constexpr int PE_VT = 49152, PE_PEXP = 114688, PE_G2 = 132096;
constexpr int PE_EPI = 122880;
constexpr int PE_PSQ = PE_PSUM + 128;
DI int vswz(int row) { return ((row >> 1) & 1) * 2 + ((row >> 3) & 1) * 4; }
DI void pv_load(const unsigned char* vqj, int tok, int pb, LAS unsigned char* lds, int lane, u32x4 (&vr)[4]) {
    const int g = lane >> 3, c = lane & 7;
#pragma unroll
    for (int i = 0; i < 4; ++i) { const int e = *((LAS const int*)(lds + PE_EIDX) + tok * 128 + pb * 32 + i * 8 + g);
        vr[i] = *(const u32x4*)(vqj + (size_t)e * 128 + (unsigned)(c * 16)); }
}
DI void pv_write(LAS unsigned char* tile, int lane, const u32x4 (&vr)[4]) {
    const int g = lane >> 3, c = lane & 7;
#pragma unroll
    for (int i = 0; i < 4; ++i) { const int row = i * 8 + g; *(LAS u32x4*)(tile + row * 128 + ((c ^ vswz(row)) * 16)) = vr[i]; }
}
DI void pv_read(LAS unsigned char* tile, int lane, u32x4 (&raw)[4]) {
    const int kg = lane >> 4, n = lane & 15;
    const int rowl = kg * 8 + (n >> 2), pc = n & 3, sw = vswz(rowl);
#pragma unroll
    for (int cb = 0; cb < 4; ++cb) {
        LAS unsigned char* p0 = tile + rowl * 128 + (((2 * cb + (pc >> 1)) ^ sw) * 16) + 8 * (pc & 1);
        const s16x4 r0 = __builtin_amdgcn_ds_read_tr16_b64_v4i16((LAS s16x4*)p0);
        const s16x4 r1 = __builtin_amdgcn_ds_read_tr16_b64_v4i16((LAS s16x4*)(p0 + 4 * 128));
        const u32x2 w0 = __builtin_bit_cast(u32x2, r0), w1 = __builtin_bit_cast(u32x2, r1);
        raw[cb] = (u32x4){w0[0], w0[1], w1[0], w1[1]};
    }
}
DI void pv_mac(int tok, int pb, LAS unsigned char* lds, int lane, const u32x4 (&raw)[4], i32x4v (&acc)[2][4]) {
    const int kg = lane >> 4, n = lane & 15;
    u32x4 ae = *(LAS const u32x4*)(lds + PE_PEXP + (tok * 128 + pb * 32 + kg * 8) * 2);
    const int shl = n == 1 ? 8 : 0;
    ae = (u32x4){ae[0] << shl, ae[1] << shl, ae[2] << shl, ae[3] << shl};
    if (n > 1) ae = (u32x4){0u, 0u, 0u, 0u};
#pragma unroll
    for (int cb = 0; cb < 4; ++cb) {
        const i32x4v lo = {(int)(raw[cb][0] & 0x0F0F0F0Fu), (int)(raw[cb][1] & 0x0F0F0F0Fu), (int)(raw[cb][2] & 0x0F0F0F0Fu), (int)(raw[cb][3] & 0x0F0F0F0Fu)};
        acc[0][cb] = __builtin_amdgcn_mfma_i32_16x16x64_i8(__builtin_bit_cast(i32x4v, ae), lo, acc[0][cb], 0, 0, 0);
        acc[1][cb] = __builtin_amdgcn_mfma_i32_16x16x64_i8(__builtin_bit_cast(i32x4v, ae), __builtin_bit_cast(i32x4v, raw[cb]), acc[1][cb], 0, 0, 0);
    }
}
DI f32x4 pv_loadx(const Args& a, int t, int j, int lane) { const u32x2 w = *(const u32x2*)((const bf16_t*)(a.ws + WS_X1B) + (size_t)t * 4096 + j * 256 + lane * 4); return (f32x4){bf_lo(w[0]), bf_hi(w[0]), bf_lo(w[1]), bf_hi(w[1])}; }
DI float pv_epi(const Args& a, int t, int tok, int j, LAS unsigned char* lds, LAS unsigned char* ebuf, int lane, const i32x4v (&acc)[2][4], const f32x4 x1) {
    const float sp = *((LAS const float*)(lds + PE_PSUM) + tok);
    const int corr = 8 * *((LAS const int*)(lds + PE_PSQ) + tok);
    if (lane < 16) {
#pragma unroll
        for (int i = 0; i < 8; ++i) { const int cb = i & 3;
            const int s0 = (i >> 2) ? (acc[1][cb][0] - acc[0][cb][0]) >> 4 : acc[0][cb][0] - corr, s1 = (i >> 2) ? (acc[1][cb][1] - acc[0][cb][1]) >> 4 : acc[0][cb][1] - corr;
            *(LAS u32x2*)(ebuf + (i * 32 + lane * 2) * 4) = (u32x2){(unsigned)s0, (unsigned)s1}; }
    }
    asm volatile("" ::: "memory");
    const i32x4v s4 = *(LAS const i32x4v*)(ebuf + lane * 16);
    const f32x4 g2 = *((LAS const f32x4*)(lds + PE_G2) + j * 64 + lane);
    const f32x4 y = {x1[0] + g2[0] * ((float)s4[0] * sp), x1[1] + g2[1] * ((float)s4[1] * sp), x1[2] + g2[2] * ((float)s4[2] * sp), x1[3] + g2[3] * ((float)s4[3] * sp)};
    *(u32x2*)((bf16_t*)(a.ws + WS_X1B) + (size_t)t * 4096 + j * 256 + lane * 4) = (u32x2){pk_bf16(y[0], y[1]), pk_bf16(y[2], y[3])};
    asm volatile("" ::: "memory");
    return y[0] * y[0] + y[1] * y[1] + y[2] * y[2] + y[3] * y[3];
}

DI void peer_tile(const Args& a, int tile, LAS unsigned char* lds) {
    const int wid = a.wid;
    const int t0 = tile * 32;
    peer_route(a, t0, 0, lds);
    __syncthreads();
    const bf16_t* h2 = (const bf16_t*)(a.ws + WS_H2); const unsigned char* uq = a.ws + WS_UB;
    const float* su = (const float*)(a.ws + WS_SU); const float* sv = (const float*)(a.ws + WS_SV);
    int lane = lane_id(); unsigned ulane = (unsigned)lane;
    unsigned char* hqg = a.ws + WS_HQ;
#pragma unroll 1
    for (int q = 0; q < 4; ++q) {
        lane = lane_id(); ulane = (unsigned)lane;
        const int tok = wid * 4 + q, t = t0 + tok;
        u32x4 hb[8]; float mx = 0.f;
#pragma unroll
        for (int c = 0; c < 4; ++c) { hb[2 * c] = *(const u32x4*)(h2 + (size_t)t * LDK + c * 1024 + ulane * 16u); hb[2 * c + 1] = *(const u32x4*)(h2 + (size_t)t * LDK + c * 1024 + ulane * 16u + 8u); }
#pragma unroll
        for (int c = 0; c < 8; ++c)
#pragma unroll
            for (int w = 0; w < 4; ++w) mx = fmaxf(mx, fmaxf(fabsf(bf_lo(hb[c][w])), fabsf(bf_hi(hb[c][w]))));
#pragma unroll
        for (int m = 32; m >= 1; m >>= 1) mx = fmaxf(mx, __shfl_xor(mx, m));
        const float inv = mx > 0.f ? 119.f / mx : 0.f;
#pragma unroll
        for (int c = 0; c < 2; ++c) { u32x4 hvh, hvl;
#pragma unroll
            for (int i = 0; i < 4; ++i) { unsigned wh = 0u, wl = 0u;
#pragma unroll
                for (int m = 0; m < 4; ++m) {
                    const unsigned wa = hb[2 * c + (i >> 1)][(i & 1) * 2 + (m >> 1)], wb = hb[2 * c + 4 + (i >> 1)][(i & 1) * 2 + (m >> 1)];
                    const int qa = (int)rintf(((m & 1) ? bf_hi(wa) : bf_lo(wa)) * inv), qb = (int)rintf(((m & 1) ? bf_hi(wb) : bf_lo(wb)) * inv);
                    const int ha = (qa + 8) >> 4, hbq = (qb + 8) >> 4;
                    wh |= ((unsigned)(ha & 15) << (8 * m)) | ((unsigned)(hbq & 15) << (8 * m + 4));
                    wl |= ((unsigned)((qa - 16 * ha) & 15) << (8 * m)) | ((unsigned)((qb - 16 * hbq) & 15) << (8 * m + 4)); }
                hvh[i] = wh; hvl[i] = wl; }
            *(u32x4*)(hqg + (size_t)t * 4096 + c * 1024 + ulane * 16u) = hvh; *(u32x4*)(hqg + (size_t)t * 4096 + (2 + c) * 1024 + ulane * 16u) = hvl; }
        if (lane == 0) *((LAS float*)(lds + PE_SH) + tok) = mx * (1.f / 119.f);
    }
    asm volatile("s_waitcnt vmcnt(0)" ::: "memory");
    __builtin_amdgcn_fence(__ATOMIC_ACQUIRE, "agent");
    lane = lane_id(); ulane = (unsigned)lane;
    u32x4 hq[4][4];
#pragma unroll
    for (int q = 0; q < 4; ++q)
#pragma unroll
        for (int c = 0; c < 4; ++c) hq[q][c] = *(const u32x4*)(hqg + (size_t)(t0 + wid * 4 + q) * 4096 + c * 1024 + ulane * 16u);
    {
        LAS unsigned* lst = (LAS unsigned*)(lds + PE_VT + wid * 8192);
        {
            int ev[8];
#pragma unroll
            for (int r = 0; r < 8; ++r) ev[r] = *((LAS const int*)(lds + PE_EIDX) + (wid * 4 + (r >> 1)) * 128 + (r & 1) * 64 + lane);
            const unsigned long long ltm = (1ull << lane) - 1ull;
            int base = 0;
#pragma unroll 1
            for (int j = 0; j < (16384 >> PEER_SLICE_SHIFT); ++j) {
#pragma unroll
                for (int r = 0; r < 8; ++r) { const bool in = (ev[r] >> PEER_SLICE_SHIFT) == j; const unsigned long long m = __ballot(in);
                    if (in) lst[base + __popcll(m & ltm)] = (unsigned)ev[r] | ((unsigned)(r >> 1) << 14) | ((unsigned)((r & 1) * 64 + lane) << 16);
                    base += __popcll(m); }
            }
        }
        asm volatile("s_waitcnt lgkmcnt(0)" ::: "memory");
        LAS int* arow = (LAS int*)(lds + PE_A) + wid * 4 * 128;
        unsigned ewA[4], ewB[4], ewC[4]; u32x4 rA[4][2], rB[4][2], rC[4][2];
        pu_issue(uq, lst, 0, ulane, ewA, rA); pu_issue(uq, lst, 1, ulane, ewB, rB); pu_issue(uq, lst, 2, ulane, ewC, rC);
#define SB __builtin_amdgcn_sched_barrier(0)
#pragma unroll 1
        for (int b = 0; b < 129; b += 3) {
            pu_compute(ewA, rA, hq, arow, lst, b, lane); SB; pu_issue(uq, lst, b + 3 < 127 ? b + 3 : 127, ulane, ewA, rA); SB;
            if (b + 1 < 128) pu_compute(ewB, rB, hq, arow, lst, b + 1, lane);
            SB; pu_issue(uq, lst, b + 4 < 127 ? b + 4 : 127, ulane, ewB, rB); SB;
            if (b + 2 < 128) pu_compute(ewC, rC, hq, arow, lst, b + 2, lane);
            SB; pu_issue(uq, lst, b + 5 < 127 ? b + 5 : 127, ulane, ewC, rC); SB;
        }
#undef SB
        asm volatile("s_waitcnt lgkmcnt(0)" ::: "memory");
    }
#pragma unroll 1
    for (int q = 0; q < 4; ++q) {
        const int tok = wid * 4 + q;
        const float sh = *((LAS const float*)(lds + PE_SH) + tok);
        float pp[2];
#pragma unroll
        for (int hf = 0; hf < 2; ++hf) { const int k = hf * 64 + lane;
            const int e = *((LAS const int*)(lds + PE_EIDX) + tok * 128 + k); const int ai = *((LAS const int*)(lds + PE_A) + tok * 128 + k);
            pp[hf] = gelu_tanh((float)ai * su[e] * sh) * *((LAS const float*)(lds + PE_GATE) + tok * 128 + k) * sv[e]; }
        float mx = fmaxf(fabsf(pp[0]), fabsf(pp[1]));
#pragma unroll
        for (int m = 32; m >= 1; m >>= 1) mx = fmaxf(mx, __shfl_xor(mx, m));
        const float inv = mx > 0.f ? 127.f / mx : 0.f;
        int qs = 0;
#pragma unroll
        for (int hf = 0; hf < 2; ++hf) { const int qi = (int)rintf(pp[hf] * inv); qs += qi; *((LAS unsigned short*)(lds + PE_PEXP) + tok * 128 + hf * 64 + lane) = (unsigned short)(qi & 255); }
#pragma unroll
        for (int m = 32; m >= 1; m >>= 1) qs += __shfl_xor(qs, m);
        if (lane == 0) { *((LAS float*)(lds + PE_PSUM) + tok) = mx * (1.f / 127.f); *((LAS int*)(lds + PE_PSQ) + tok) = qs; }
    }
    float ssq[4] = {0.f, 0.f, 0.f, 0.f};
    {
        const int tk = wid * 4, tg = t0 + wid * 4;
        LAS unsigned char* vt = lds + PE_VT + wid * 8192;
        LAS unsigned char* ebuf = lds + PE_EPI + wid * 1024;
        const unsigned char* vq = a.ws + WS_VB;
        u32x4 vb[8][4]; f32x4 xa, xb;
        lane = lane_id();
        xa = pv_loadx(a, tg, 0, lane);
#pragma unroll
        for (int pb = 0; pb < 4; ++pb) pv_load(vq, tk, pb, lds, lane, vb[pb]);
        xb = pv_loadx(a, tg + 1, 0, lane);
#pragma unroll
        for (int pb = 0; pb < 4; ++pb) pv_load(vq, tk + 1, pb, lds, lane, vb[4 + pb]);
        pv_write(vt, lane, vb[0]);
        pv_load(vq, tk + 2, 0, lds, lane, vb[0]);
#pragma unroll 1
        for (int j = 0; j < 16; ++j) {
            lane = lane_id();
            const int jn = j < 15 ? j + 1 : 15;
            const unsigned char* vqj = vq + (size_t)j * (16384 * 128);
            const unsigned char* vqn = vq + (size_t)jn * (16384 * 128);
#define SB do {} while (0)
#pragma unroll
            for (int q = 0; q < 4; ++q) {
                i32x4v acc[2][4];
#pragma unroll
                for (int i = 0; i < 8; ++i) acc[i >> 2][i & 3] = (i32x4v){0, 0, 0, 0};
#pragma unroll
                for (int pb = 0; pb < 4; ++pb) {
                    const int i = q * 4 + pb, in = (i + 1) & 15;
                    u32x4 raw[4];
                    pv_read(vt + (i & 1) * 4096, lane, raw);
                    asm volatile("" ::: "memory"); SB;
                    pv_write(vt + ((i + 1) & 1) * 4096, lane, vb[in & 7]);
                    asm volatile("" ::: "memory"); SB;
                    {
                        const int qn = (in >> 2) + 2, pbn = in & 3;
                        const bool nexts = (i == 15) || (qn >= 4);
                        const int qq = (i == 15) ? 2 : (qn & 3);
                        pv_load(nexts ? vqn : vqj, tk + qq, pbn, lds, lane, vb[in & 7]);
                    }
                    SB;
                    pv_mac(tk + q, pb, lds, lane, raw, acc); SB;
                    if (pb == 3) { ssq[q] += pv_epi(a, tg + q, tk + q, j, lds, ebuf, lane, acc, (q & 1) ? xb : xa); SB;
                        const f32x4 xn = q < 2 ? pv_loadx(a, tg + q + 2, j, lane) : pv_loadx(a, tg + q - 2, jn, lane);
                        if (q & 1) xb = xn; else xa = xn; SB; }
                }
            }
#undef SB
        }
    }
    asm volatile("s_waitcnt vmcnt(0)" ::: "memory");
    __builtin_amdgcn_fence(__ATOMIC_ACQUIRE, "agent");
    const float* fg = a.in[I_FG];
#pragma unroll
    for (int q = 0; q < 4; ++q) {
        lane = lane_id(); ulane = (unsigned)lane;
        const float ss = wave_sum(ssq[q]);
        const float rs = rsqrtf(ss * (1.f / 4096.f) + EPS);
        const bf16_t* xr = (const bf16_t*)(a.ws + WS_X1B) + (size_t)(t0 + wid * 4 + q) * 4096;
        float* orow = a.out + (size_t)(t0 + wid * 4 + q) * 4096;
#pragma unroll
        for (int c = 0; c < 8; ++c) { const unsigned col = (unsigned)c * 512u + ulane * 8u; const u32x4 w = *(const u32x4*)(xr + col); const f32x4 f0 = *(const f32x4*)(fg + col), f1 = *(const f32x4*)(fg + col + 4);
            *(f32x4*)(orow + col) = (f32x4){bf_lo(w[0]) * rs * f0[0], bf_hi(w[0]) * rs * f0[1], bf_lo(w[1]) * rs * f0[2], bf_hi(w[1]) * rs * f0[3]};
            *(f32x4*)(orow + col + 4) = (f32x4){bf_lo(w[2]) * rs * f1[0], bf_hi(w[2]) * rs * f1[1], bf_lo(w[3]) * rs * f1[2], bf_hi(w[3]) * rs * f1[3]};
            if ((c & 1) == 1) asm volatile("" ::: "memory"); }
    }
    __syncthreads();
}
DI void phase_peer(const Args& a, LAS unsigned char* lds) {
    { const int tid = a.wid * 64 + lane_id(); const float* gate2 = (const float*)(a.ws + WS_MOD) + 5 * 4096;
      for (int i = tid; i < 1024; i += NTHREADS) *((LAS f32x4*)(lds + PE_G2) + i) = *((const f32x4*)gate2 + i); }
    for (int tile = blockIdx.x; tile < T / 32; tile += gridDim.x) peer_tile(a, tile, lds);
}

constexpr int N_PHASES = 12;
__global__ void __launch_bounds__(NTHREADS, 2) mk_fwd(Args a_in) {
    Args a = a_in; a.wid = __builtin_amdgcn_readfirstlane(threadIdx.x >> 6);
    extern __shared__ __attribute__((aligned(16))) unsigned char shm_raw[];
    LAS unsigned char* lds = (LAS unsigned char*)shm_raw;
    if (threadIdx.x == 0) *(LAS u32x4*)(lds + LDS_BAR_OFF) = (u32x4){0u, 0u, 0u, 0u};
    __syncthreads();
    unsigned* ctl = (unsigned*)(a.ws + WS_CTL);
    XcdBarrier bar = xcd_barrier_post(ctl + CW_BAR, (volatile LAS unsigned*)(lds + LDS_BAR_OFF)); bar.wid = a.wid;
    const float* mod = (const float*)(a.ws + WS_MOD);
#ifdef MK_ONLY
#define RUN(k) ((k) == MK_ONLY)
#else
#define RUN(k) (a.ph_lo <= (k) && (k) < a.ph_hi)
#endif
#define SEAM(k) do { if (a.ph_lo <= (k) && (k) + 1 < a.ph_hi) xcd_barrier(bar); } while (0)
    if (RUN(0)) phase_prologue(a, lds);
    SEAM(0);
    if (RUN(1)) phase_norm_mod(a, a.in[I_X], a.in[I_N1G], mod, mod + 4096, (bf16_t*)(a.ws + WS_H1), lds);
    SEAM(1);
    if (RUN(2)) { pg8::StaticOrder S; S.init(T, NPAD, gridDim.x, blockIdx.x);
        pg8::gemm_phase(a.wid, lds, pg8::Gemm{(const bf16_t*)(a.ws + WS_H1), (const bf16_t*)(a.ws + WS_WIN), T, NPAD, 4096, LDK}, S, pg8::EpiProj{(bf16_t*)(a.ws + WS_PROJ), NPAD, (bf16_t*)(a.ws + WS_RVT), (bf16_t*)(a.ws + WS_FVT), (bf16_t*)(a.ws + WS_RQ), (bf16_t*)(a.ws + WS_RK), (bf16_t*)(a.ws + WS_RKT), (const float*)(a.ws + WS_COS), (const float*)(a.ws + WS_SIN)});
        phase_ff(a, lds);
    }
    SEAM(2);
    if (RUN(3)) phase_prep(a, lds);
    if (RUN(4)) phase_ret_kv(a, lds);
    SEAM(4);
    if (RUN(6)) phase_mixer(a, lds);
    SEAM(6);
    if (RUN(7)) phase_fox_norm(a);
    SEAM(7);
    if (RUN(8)) { pg8::StaticOrder S; S.init(T, 4096, gridDim.x, blockIdx.x);
        pg8::gemm_phase(a.wid, lds, pg8::Gemm{(const bf16_t*)(a.ws + WS_H1), (const bf16_t*)(a.ws + WS_WOUT), T, 4096, 4096, LDK}, S, pg8::EpiResGate{(bf16_t*)(a.ws + WS_X1B), a.in[I_X], mod + 2 * 4096, 4096});
    }
    SEAM(8);
    if (RUN(9)) phase_norm_mod_bf(a, (const bf16_t*)(a.ws + WS_X1B), a.in[I_N2G], mod + 3 * 4096, mod + 4 * 4096, (bf16_t*)(a.ws + WS_H2), lds);
    SEAM(9);
    if (RUN(10)) { pg8::StaticOrder S; S.init(T, 2048, gridDim.x, blockIdx.x);
        pg8::gemm_phase(a.wid, lds, pg8::Gemm{(const bf16_t*)(a.ws + WS_H2), (const bf16_t*)(a.ws + WS_WPQ), T, 2048, 4096, LDK}, S, pg8::EpiBf16{(bf16_t*)(a.ws + WS_QP), 2048});
    }
    SEAM(10);
    if (RUN(11)) phase_peer(a, lds);
#undef RUN
#undef SEAM
}

#ifndef MK_N_LAUNCHES
#define MK_N_LAUNCHES 1
#endif
extern "C" void kernel_launch(void* const* d_in, const int* in_sizes, int n_in, void* d_out, int out_size, void* d_ws, size_t ws_size, hipStream_t stream) {
    static int grid = 0;
    if (grid == 0) {
        if (n_in != 17 || out_size != T * D || ws_size < WS_END) { fprintf(stderr, "kernel_launch: unexpected shapes (n_in %d, out %d, ws %zu < %zu)\n", n_in, out_size, ws_size, (size_t)WS_END); grid = -1; return; }
        int dev = 0, cus = 0, per_cu = 0;
        if (hipGetDevice(&dev) != hipSuccess || hipDeviceGetAttribute(&cus, hipDeviceAttributeMultiprocessorCount, dev) != hipSuccess) { grid = -1; return; }
        if (hipFuncSetAttribute((const void*)mk_fwd, hipFuncAttributeMaxDynamicSharedMemorySize, LDS_BYTES) != hipSuccess) { fprintf(stderr, "kernel_launch: hipFuncSetAttribute failed\n"); grid = -1; return; }
        if (hipOccupancyMaxActiveBlocksPerMultiprocessor(&per_cu, (const void*)mk_fwd, NTHREADS, LDS_BYTES) != hipSuccess || per_cu < 1) { fprintf(stderr, "kernel_launch: occupancy query says %d\n", per_cu); (void)hipGetLastError(); per_cu = 1; }
        grid = cus;
    }
    if (grid < 0) return;
    (void)in_sizes;
    (void)hipMemsetAsync((char*)d_ws + WS_CTL, 0, CTL_BYTES, stream);
    Args a{};
    for (int i = 0; i < 17; ++i) a.in[i] = (const float*)d_in[i];
    a.out = (float*)d_out; a.ws = (unsigned char*)d_ws;
    for (int li = 0; li < MK_N_LAUNCHES; ++li) {
        a.ph_lo = li * N_PHASES / MK_N_LAUNCHES; a.ph_hi = (li + 1) * N_PHASES / MK_N_LAUNCHES;
        hipLaunchKernelGGL(mk_fwd, dim3(grid), dim3(NTHREADS), LDS_BYTES, stream, a);
    }
}
```

```cpp
#include <hip/hip_runtime.h>
#include <cstdio>
#include <cstdint>

#define DI __device__ __forceinline__
#define LAS __attribute__((address_space(3)))
typedef unsigned short bf16_t;
typedef short bf16x8 __attribute__((ext_vector_type(8)));
typedef float f32x2 __attribute__((ext_vector_type(2)));
typedef float f32x4 __attribute__((ext_vector_type(4)));
typedef float f32x16 __attribute__((ext_vector_type(16)));
typedef unsigned u32x2 __attribute__((ext_vector_type(2)));
typedef unsigned u32x4 __attribute__((ext_vector_type(4)));
typedef __bf16 bf16v2 __attribute__((ext_vector_type(2)));
typedef short s16x4 __attribute__((ext_vector_type(4)));
typedef int i32x4v __attribute__((ext_vector_type(4)));

constexpr int T = 16384, D = 4096, INW = 12304, NPAD = 12288;
constexpr int C_RQ = 0, C_RK = 1024, C_RV = 2048, C_RG = 4096, C_FQ = 6144, C_FK = 8192, C_FV = 10240;
constexpr int LDK = 4160;
constexpr int NTHREADS = 512;
constexpr int LDS_BYTES = 155648;
constexpr int LDS_BAR_OFF = 131072;
constexpr int LDS_MISC_OFF = 131072 + 64;
constexpr float LOG2E = 1.4426950408889634f;
constexpr float EPS = 1e-6f;

constexpr size_t WS_CTL  = 0;
constexpr size_t CTL_BYTES = 65536;
constexpr size_t WS_MOD  = WS_CTL + CTL_BYTES;
constexpr size_t WS_COS  = WS_MOD + 98304;
constexpr size_t WS_SIN  = WS_COS + (size_t)T * 64 * 4;
constexpr size_t WS_SKB  = WS_SIN + (size_t)T * 64 * 4;
constexpr size_t WS_CUM  = WS_SKB + 524288;
constexpr size_t WS_SU   = WS_CUM + (size_t)16 * T * 4;
constexpr size_t WS_SV   = WS_SU + 65536;
constexpr size_t WS_FF   = WS_SV + 65536;
constexpr size_t WS_WIN  = WS_FF + (size_t)T * 16 * 4;
constexpr size_t WS_WOUT = WS_WIN + (size_t)INW * LDK * 2;
constexpr size_t WS_WPQ  = WS_WOUT + (size_t)4096 * LDK * 2;
constexpr size_t WS_UB   = WS_WPQ + (size_t)2048 * LDK * 2;
constexpr size_t WS_VB   = WS_UB + (size_t)16384 * 4096;
constexpr size_t WS_H1   = WS_VB + (size_t)16384 * 4096;
constexpr size_t WS_PROJ = WS_H1 + (size_t)T * LDK * 2;
constexpr size_t WS_KV   = WS_PROJ + (size_t)T * NPAD * 2;
constexpr size_t WS_RQ   = WS_KV + (size_t)128 * 8 * 256 * 128 * 4;
constexpr size_t WS_RK   = WS_RQ + (size_t)T * 1024 * 2;
constexpr size_t WS_RKT  = WS_RK + (size_t)T * 1024 * 2;
constexpr size_t WS_RVT  = WS_RKT + (size_t)T * 1024 * 2;
constexpr size_t WS_FVT  = WS_RVT + (size_t)T * 2048 * 2;
constexpr size_t WS_END  = WS_FVT + (size_t)T * 2048 * 2;
constexpr size_t WS_H2   = WS_PROJ;
constexpr size_t WS_QP   = WS_PROJ + (size_t)T * LDK * 2;
constexpr int X1P = LDK;
constexpr size_t WS_X1B  = WS_QP + (size_t)T * 2048 * 2;

constexpr int CW_BAR = 0;
constexpr int CW_QUEUE = 8192;
constexpr int CW_KMAX = 8448;
constexpr int CW_SCAN = 8704;

DI unsigned pk_bf16(float lo, float hi) { f32x2 v = {lo, hi}; bf16v2 b = __builtin_convertvector(v, bf16v2); return __builtin_bit_cast(unsigned, b); }
DI float bf_lo(unsigned w) { return __uint_as_float(w << 16); }
DI float bf_hi(unsigned w) { return __uint_as_float(w & 0xffff0000u); }
DI float bf2f(bf16_t b) { return __uint_as_float(((unsigned)b) << 16); }
DI bf16_t f2bf(float f) { return (bf16_t)(pk_bf16(f, 0.f) & 0xffffu); }
DI float wave_sum(float v) {
#pragma unroll
    for (int m = 32; m >= 1; m >>= 1) v += __shfl_xor(v, m);
    return v;
}
DI float swap32_max(float x) { auto rr = __builtin_amdgcn_permlane32_swap(__float_as_uint(x), __float_as_uint(x), false, false); return fmaxf(__uint_as_float(rr[0]), __uint_as_float(rr[1])); }
DI float swap32_sum(float x) { auto rr = __builtin_amdgcn_permlane32_swap(__float_as_uint(x), __float_as_uint(x), false, false); return __uint_as_float(rr[0]) + __uint_as_float(rr[1]); }
DI float swap32_other(float x, int hh) { auto rr = __builtin_amdgcn_permlane32_swap(__float_as_uint(x), __float_as_uint(x), false, false); return __uint_as_float(hh ? rr[0] : rr[1]); }
DI int lane_id() { int l; asm volatile("v_mbcnt_lo_u32_b32 %0, -1, 0\n\tv_mbcnt_hi_u32_b32 %0, -1, %0" : "=v"(l)); return l; }
DI int crow(int reg, int hh) { return (reg & 3) + 8 * (reg >> 2) + 4 * hh; }
#define MFMA32(a, b, c) __builtin_amdgcn_mfma_f32_32x32x16_bf16((a), (b), (c), 0, 0, 0)
DI bf16x8 pack8(float a0, float a1, float a2, float a3, float a4, float a5, float a6, float a7) {
    u32x4 w = {pk_bf16(a0, a1), pk_bf16(a2, a3), pk_bf16(a4, a5), pk_bf16(a6, a7)};
    return __builtin_bit_cast(bf16x8, w);
}
DI float dot2bf(unsigned a, unsigned b, float c) { return __builtin_amdgcn_fdot2_f32_bf16(__builtin_bit_cast(bf16v2, a), __builtin_bit_cast(bf16v2, b), c, false); }
DI float silu_f(float x) { return x / (1.f + __expf(-x)); }
DI float gelu_tanh(float x) {
    const float u = 0.7978845608028654f * (x + 0.044715f * x * x * x);
    const float t = 1.f - 2.f / (1.f + __expf(2.f * u));
    return 0.5f * x * (1.f + t);
}

#define XB_TMO      128
#define XB_XCNT(j)  (256  + 64 * (j))
#define XB_XSUB(j)  (1280 + 64 * (j))
#define XB_XGEN(j)  (2304 + 64 * (j))
#define XB_TOP      3328
#define XB_TOPGEN   3392
#define XCD_BAR_WORDS 3456
#define XB_SPIN_CAP (1u << 27)
DI unsigned xb_ld(unsigned* p)              { return __hip_atomic_load(p, __ATOMIC_RELAXED, __HIP_MEMORY_SCOPE_AGENT); }
DI unsigned xb_add(unsigned* p, unsigned v) { return __hip_atomic_fetch_add(p, v, __ATOMIC_RELAXED, __HIP_MEMORY_SCOPE_AGENT); }
DI unsigned xb_xcc_id() { return (unsigned)__builtin_amdgcn_s_getreg((3 << 11) | 20) & 0xFu; }
#define XB_SPIN(cond, bar) do { unsigned _sp = 0; while (cond) { __builtin_amdgcn_s_sleep(1); \
    if ((++_sp & 255u) == 0u) { if (xb_ld(&(bar)[XB_TMO])) break; if (_sp > XB_SPIN_CAP) { atomicAdd(&(bar)[XB_TMO], 1u); break; } } } } while (0)
struct XcdBarrier { unsigned* bar; unsigned x; volatile LAS unsigned* st; int wid; };
DI XcdBarrier xcd_barrier_post(unsigned* bar, volatile LAS unsigned* st) {
    XcdBarrier b; b.bar = bar; b.x = xb_xcc_id(); b.st = st;
    if (threadIdx.x == 0) (void)xb_add(&bar[XB_XCNT(b.x)], 1u);
    return b;
}
DI void xcd_barrier_complete(unsigned* bar, unsigned x, unsigned& nloc, unsigned& nx) {
    const unsigned G = gridDim.x * gridDim.y * gridDim.z;
    unsigned sum, cnt, mine, sp = 0u;
    for (;;) {
        sum = 0u; cnt = 0u; mine = 0u;
#pragma unroll
        for (unsigned j = 0; j < 16; ++j) { const unsigned c = xb_ld(&bar[XB_XCNT(j)]); sum += c; cnt += (c > 0u) ? 1u : 0u; mine = (j == x) ? c : mine; }
        if (sum == G) break;
        __builtin_amdgcn_s_sleep(1);
        if ((++sp & 255u) == 0u) { if (xb_ld(&bar[XB_TMO])) break; if (sp > XB_SPIN_CAP) { atomicAdd(&bar[XB_TMO], 1u); break; } }
    }
    nloc = mine > 0u ? mine : 1u; nx = cnt > 0u ? cnt : 1u;
}
DI void xcd_barrier(const XcdBarrier& b) {
    asm volatile("s_waitcnt vmcnt(0)" ::: "memory");
    __syncthreads();
    if (b.wid == 0 && lane_id() == 0) {
        unsigned* bar = b.bar;
        __builtin_amdgcn_s_waitcnt(0);
        unsigned nloc = b.st[0], nx = b.st[1];
        if (nloc == 0u) { xcd_barrier_complete(bar, b.x, nloc, nx); b.st[0] = nloc; b.st[1] = nx; }
        const unsigned old = xb_add(&bar[XB_XSUB(b.x)], 1u);
        const unsigned gen = old / nloc;
        if (old + 1u == (gen + 1u) * nloc) {
            __builtin_amdgcn_fence(__ATOMIC_RELEASE, "agent");
            asm volatile("s_waitcnt vmcnt(0)" ::: "memory");
            const unsigned og = xb_add(&bar[XB_TOP], 1u);
            const unsigned tg = og / nx;
            if (og + 1u == (tg + 1u) * nx) xb_add(&bar[XB_TOPGEN], 1u);
            else XB_SPIN(xb_ld(&bar[XB_TOPGEN]) == tg, bar);
            __builtin_amdgcn_fence(__ATOMIC_ACQUIRE, "agent");
            xb_add(&bar[XB_XGEN(b.x)], 1u);
            asm volatile("s_waitcnt vmcnt(0)" ::: "memory");
        } else {
            XB_SPIN(xb_ld(&bar[XB_XGEN(b.x)]) == gen, bar);
            __builtin_amdgcn_fence(__ATOMIC_ACQUIRE, "agent");
            asm volatile("s_waitcnt vmcnt(0)" ::: "memory");
        }
    }
    __syncthreads();
}

namespace pg8 {
constexpr int BM = 256, BK = 64, HALF = 128, HTB = HALF * BK * 2, STAGE_BYTES = 8 * HTB, NXCD = 8, WGM = 8;
DI int lds_byte(int r, int c) { const int st = (r >> 4) * 2 + (c >> 5), rr = r & 15, cc = c & 31, ob = rr * 64 + cc * 2; return st * 1024 + (ob ^ (((ob >> 9) & 1) << 5)); }
DI void stage_rc(int b, int& R, int& C) { const int st = b / 1024, sb = b % 1024, swz = sb ^ (((sb >> 9) & 1) << 5); R = (st >> 1) * 16 + swz / 64; C = (st & 1) * 32 + (swz % 64) / 2; }
DI int perm32(int rho) { const int n = rho >> 4, i = rho & 15; return 8 * (i >> 2) + 4 * n + (i & 3); }
struct Unit { int pm, pn; };
struct Gemm { const bf16_t* A; const bf16_t* Bt; int M, N, K, ld; };
struct StaticOrder {
    int nM, nN, nwg, G, c;
    DI void init(int M, int N, int G_, int c_) { nM = M / BM; nN = N / BM; nwg = nM * nN; G = G_; c = c_; }
    DI bool next(int i, Unit& u) const {
        const long L = (long)i * G + c; if (L >= nwg) return false;
        int wgid = (int)L; { const int q = nwg / NXCD, r = nwg % NXCD, xcd = wgid % NXCD, off = wgid / NXCD; wgid = (xcd < r ? xcd * (q + 1) : r * (q + 1) + (xcd - r) * q) + off; }
        const int nig = WGM * nN, gid = wgid / nig, fm = gid * WGM, gsz = (nM - fm) < WGM ? (nM - fm) : WGM;
        u.pm = fm + ((wgid % nig) % gsz); u.pn = (wgid % nig) / gsz; return true;
    }
    DI void a_ready(const Unit&) const {}
    DI void done(const Unit&) const {}
};
struct ProbeOrder : StaticOrder { DI bool next(int i, Unit& u) const { const bool ok = StaticOrder::next(i, u); u.pm = 0; u.pn = 0; return ok; } };
struct EpiBf16 {
    static constexpr int PERM = 2;
    bf16_t* O; int ldc;
    DI void operator()(const f32x4 (&acc)[2][2][4][2], const Unit& u, int wr, int wc, int fr, int fq) const {
        const int row0 = u.pm * BM + wr * 64 + fr; const int col0 = u.pn * BM + wc * 64 + 8 * fq;
        const bool oddr = fr & 1;
#pragma unroll
        for (int ai = 0; ai < 2; ++ai)
#pragma unroll
            for (int m = 0; m < 4; ++m) { const int trow = row0 + ai * HALF + m * 16;
                u32x4 w[2];
#pragma unroll
                for (int bj = 0; bj < 2; ++bj) { const f32x4 v0 = acc[ai][bj][m][0], v1 = acc[ai][bj][m][1];
                    w[bj] = (u32x4){pk_bf16(v0[0], v0[1]), pk_bf16(v0[2], v0[3]), pk_bf16(v1[0], v1[1]), pk_bf16(v1[2], v1[3])}; }
                const u32x4 give = oddr ? w[0] : w[1]; u32x4 got;
#pragma unroll
                for (int k = 0; k < 4; ++k) got[k] = (unsigned)__builtin_amdgcn_update_dpp(0, (int)give[k], 0xB1, 0xf, 0xf, false);
                bf16_t* pe = O + (size_t)(trow - (oddr ? 1 : 0)) * ldc + col0 + (oddr ? 32 : 0);
                __builtin_nontemporal_store(oddr ? got : w[0], (u32x4*)pe);
                __builtin_nontemporal_store(oddr ? w[1] : got, (u32x4*)(pe + ldc)); }
    }
};
struct EpiProj {
    static constexpr int PERM = 2;
    bf16_t* O; int ldc; bf16_t* rvt; bf16_t* fvt; bf16_t* rq; bf16_t* rk; bf16_t* rkt; const float* ct; const float* st;
    DI static void quad_transpose(f32x4& v, int lane) {
        const bool odd = lane & 1, hi = lane & 2;
        { const float s0 = odd ? v[0] : v[1], s1 = odd ? v[2] : v[3];
          const float r0 = __uint_as_float(__builtin_amdgcn_update_dpp(0, (int)__float_as_uint(s0), 0xB1, 0xf, 0xf, false)), r1 = __uint_as_float(__builtin_amdgcn_update_dpp(0, (int)__float_as_uint(s1), 0xB1, 0xf, 0xf, false));
          if (odd) { v[0] = r0; v[2] = r1; } else { v[1] = r0; v[3] = r1; } }
        { const float s0 = hi ? v[0] : v[2], s1 = hi ? v[1] : v[3];
          const float r0 = __uint_as_float(__builtin_amdgcn_update_dpp(0, (int)__float_as_uint(s0), 0x4E, 0xf, 0xf, false)), r1 = __uint_as_float(__builtin_amdgcn_update_dpp(0, (int)__float_as_uint(s1), 0x4E, 0xf, 0xf, false));
          if (hi) { v[0] = r0; v[1] = r1; } else { v[2] = r0; v[3] = r1; } }
    }
    DI void operator()(const f32x4 (&acc)[2][2][4][2], const Unit& u, int wr, int wc, int fr_, int fq_) const {
        const int lid = lane_id(), fr = lid & 15, fq = lid >> 4; (void)fr_; (void)fq_;
        const bool isrv = (u.pn >= 8 && u.pn < 16), isfv = (u.pn >= 40);
        if (u.pn < 8) {
            const bool isk = u.pn >= 4; const float sc = isk ? 0.08838834764831845f : 1.0f;
            bf16_t* dn = isk ? rk : rq;
            const int lane = fq * 16 + fr;
#pragma unroll
            for (int ai = 0; ai < 2; ++ai)
#pragma unroll
                for (int m = 0; m < 4; ++m) { const int t = u.pm * BM + wr * 64 + fr + ai * HALF + m * 16;
                    u32x4 wq[2];
#pragma unroll
                    for (int bj = 0; bj < 2; ++bj) { const int ctile = wc * 64 + bj * 32 + 8 * fq;
                        const int h = (u.pn & 3) * 2 + (ctile >> 7), p0 = ctile & 127;
                        const f32x4 cs = *(const f32x4*)(ct + (size_t)t * 64 + (p0 >> 1)), sn = *(const f32x4*)(st + (size_t)t * 64 + (p0 >> 1));
                        const f32x4 v0 = acc[ai][bj][m][0], v1 = acc[ai][bj][m][1];
                        f32x4 o0 = {(v0[0] * cs[0] - v0[1] * sn[0]) * sc, (v0[0] * sn[0] + v0[1] * cs[0]) * sc, (v0[2] * cs[1] - v0[3] * sn[1]) * sc, (v0[2] * sn[1] + v0[3] * cs[1]) * sc};
                        f32x4 o1 = {(v1[0] * cs[2] - v1[1] * sn[2]) * sc, (v1[0] * sn[2] + v1[1] * cs[2]) * sc, (v1[2] * cs[3] - v1[3] * sn[3]) * sc, (v1[2] * sn[3] + v1[3] * cs[3]) * sc};
                        wq[bj] = (u32x4){pk_bf16(o0[0], o0[1]), pk_bf16(o0[2], o0[3]), pk_bf16(o1[0], o1[1]), pk_bf16(o1[2], o1[3])};
                        if (isk) {
                            const float lg2 = log1pf(-exp2f(-5.f - (float)h)) * LOG2E;
                            const int tq = t & ~3;
                            const float d0 = exp2f((float)(127 - (tq & 127)) * lg2), d1 = exp2f((float)(126 - (tq & 127)) * lg2), d2 = exp2f((float)(125 - (tq & 127)) * lg2), d3 = exp2f((float)(124 - (tq & 127)) * lg2);
                            quad_transpose(o0, lane); quad_transpose(o1, lane);
                            bf16_t* kt = rkt + (size_t)(h * 128 + p0 + (fr & 3)) * T + tq;
                            *(u32x2*)kt = (u32x2){pk_bf16(o0[0] * d0, o0[1] * d1), pk_bf16(o0[2] * d2, o0[3] * d3)};
                            *(u32x2*)(kt + (size_t)4 * T) = (u32x2){pk_bf16(o1[0] * d0, o1[1] * d1), pk_bf16(o1[2] * d2, o1[3] * d3)};
                        } }
                    {
                        const bool oddr = fr & 1; const u32x4 give = oddr ? wq[0] : wq[1]; u32x4 got;
#pragma unroll
                        for (int k = 0; k < 4; ++k) got[k] = (unsigned)__builtin_amdgcn_update_dpp(0, (int)give[k], 0xB1, 0xf, 0xf, false);
                        bf16_t* pe = dn + (size_t)(t - (oddr ? 1 : 0)) * 1024 + (u.pn & 3) * 256 + wc * 64 + (oddr ? 32 : 0) + 8 * fq;
                        __builtin_nontemporal_store(oddr ? got : wq[0], (u32x4*)pe);
                        __builtin_nontemporal_store(oddr ? wq[1] : got, (u32x4*)(pe + 1024)); }
                    __builtin_amdgcn_sched_barrier(0); }
        } else if (!(isrv || isfv)) {
            const int row0 = u.pm * BM + wr * 64 + fr; const int col0 = u.pn * BM + wc * 64 + 8 * fq;
            const bool oddr = fr & 1;
#pragma unroll
            for (int ai = 0; ai < 2; ++ai)
#pragma unroll
                for (int m = 0; m < 4; ++m) { const int trow = row0 + ai * HALF + m * 16;
                    u32x4 w[2];
#pragma unroll
                    for (int bj = 0; bj < 2; ++bj) { const f32x4 v0 = acc[ai][bj][m][0], v1 = acc[ai][bj][m][1];
                        w[bj] = (u32x4){pk_bf16(v0[0], v0[1]), pk_bf16(v0[2], v0[3]), pk_bf16(v1[0], v1[1]), pk_bf16(v1[2], v1[3])}; }
                    const u32x4 give = oddr ? w[0] : w[1]; u32x4 got;
#pragma unroll
                    for (int k = 0; k < 4; ++k) got[k] = (unsigned)__builtin_amdgcn_update_dpp(0, (int)give[k], 0xB1, 0xf, 0xf, false);
                    bf16_t* pe = O + (size_t)(trow - (oddr ? 1 : 0)) * ldc + col0 + (oddr ? 32 : 0);
                    __builtin_nontemporal_store(oddr ? got : w[0], (u32x4*)pe);
                    __builtin_nontemporal_store(oddr ? w[1] : got, (u32x4*)(pe + ldc)); }
        } else {
            bf16_t* vt = isrv ? rvt + (size_t)(u.pn - 8) * BM * T : fvt + (size_t)(u.pn - 40) * BM * T;
            const int lane = fq * 16 + fr;
            const int g = fr >> 2;
            const int rowb = u.pm * BM + wr * 64 + 8 * (g >> 1);
            const int colq = wc * 64 + 8 * fq + (fr & 3);
            const bool odd = g & 1;
#pragma unroll
            for (int ai = 0; ai < 2; ++ai)
#pragma unroll
                for (int bj = 0; bj < 2; ++bj)
#pragma unroll
                    for (int n = 0; n < 2; ++n) {
                        u32x2 q[4];
#pragma unroll
                        for (int m = 0; m < 4; ++m) { f32x4 v = acc[ai][bj][m][n]; quad_transpose(v, lane); q[m] = (u32x2){pk_bf16(v[0], v[1]), pk_bf16(v[2], v[3])}; }
                        u32x4 W[2];
#pragma unroll
                        for (int j = 0; j < 2; ++j) {
                            const u32x2 keep = odd ? q[2 * j + 1] : q[2 * j], give = odd ? q[2 * j] : q[2 * j + 1];
                            const u32x2 got = {(unsigned)__shfl_xor((int)give[0], 4), (unsigned)__shfl_xor((int)give[1], 4)};
                            W[j] = odd ? (u32x4){got[0], got[1], keep[0], keep[1]} : (u32x4){keep[0], keep[1], got[0], got[1]}; }
                        const bool qodd = fr & 1; const u32x4 give2 = qodd ? W[0] : W[1]; u32x4 got2;
#pragma unroll
                        for (int k = 0; k < 4; ++k) got2[k] = (unsigned)__builtin_amdgcn_update_dpp(0, (int)give2[k], 0xB1, 0xf, 0xf, false);
                        bf16_t* cp = vt + (size_t)(colq - (qodd ? 1 : 0) + bj * 32 + 4 * n) * T + rowb + ai * HALF + (2 * (qodd ? 1 : 0) + (odd ? 1 : 0)) * 16;
                        __builtin_nontemporal_store(qodd ? got2 : W[0], (u32x4*)cp);
                        __builtin_nontemporal_store(qodd ? W[1] : got2, (u32x4*)(cp + T));
                    }
        }
    }
};
struct EpiResGate {
    static constexpr int PERM = 3;
    bf16_t* C; const float* res; const float* gate; int ldc, ldo;
    DI void operator()(const f32x4 (&acc)[2][2][4][2], const Unit& u, int wr, int wc, int fr, int fq) const {
        const int row0 = u.pm * BM + wr * 64 + fr, colb = u.pn * BM + wc * 64;
        const bool oddr = fr & 1, oddq = fq & 1;
        const int cst = oddq ? 16 + 4 * (fq - 1) : 4 * fq;
        f32x4 gv[2][2];
#pragma unroll
        for (int bj = 0; bj < 2; ++bj)
#pragma unroll
            for (int n = 0; n < 2; ++n) gv[bj][n] = *(const f32x4*)(gate + colb + bj * 32 + n * 16 + 4 * fq);
#pragma unroll
        for (int ai = 0; ai < 2; ++ai)
#pragma unroll
            for (int m = 0; m < 4; ++m) { const int row = row0 + ai * HALF + m * 16; const size_t ro = (size_t)row * ldc + colb;
                u32x4 w[2];
#pragma unroll
                for (int bj = 0; bj < 2; ++bj) { const f32x4 x0 = *(const f32x4*)(res + ro + bj * 32 + 4 * fq), x1 = *(const f32x4*)(res + ro + bj * 32 + 16 + 4 * fq);
                    const f32x4 y0 = x0 + gv[bj][0] * acc[ai][bj][m][0], y1 = x1 + gv[bj][1] * acc[ai][bj][m][1];
                    const u32x2 p0 = {pk_bf16(y0[0], y0[1]), pk_bf16(y0[2], y0[3])}, p1 = {pk_bf16(y1[0], y1[1]), pk_bf16(y1[2], y1[3])};
                    const u32x2 gq = oddq ? p0 : p1;
                    const u32x2 tq = {(unsigned)__builtin_amdgcn_ds_swizzle((int)gq[0], 0x401F), (unsigned)__builtin_amdgcn_ds_swizzle((int)gq[1], 0x401F)};
                    w[bj] = oddq ? (u32x4){tq[0], tq[1], p1[0], p1[1]} : (u32x4){p0[0], p0[1], tq[0], tq[1]}; }
                const u32x4 give = oddr ? w[0] : w[1];
                u32x4 got;
#pragma unroll
                for (int k = 0; k < 4; ++k) got[k] = (unsigned)__builtin_amdgcn_update_dpp(0, (int)give[k], 0xB1, 0xf, 0xf, false);
                bf16_t* pe = C + (size_t)(row - (oddr ? 1 : 0)) * ldo + colb + (oddr ? 32 : 0) + cst;
                __builtin_nontemporal_store(oddr ? got : w[0], (u32x4*)pe);
                __builtin_nontemporal_store(oddr ? w[1] : got, (u32x4*)(pe + ldo)); }
    }
};

template <class Epi, class Sched>
DI void gemm_phase(int wid_in, LAS unsigned char* lds, const Gemm g, const Sched& S, const Epi& E) {
    const int wid = wid_in, lane = lane_id(), tid = wid * 64 + lane, wr = wid >> 2, wc = wid & 3, fr = lane & 15, fq = lane >> 4;
    const int K = g.K, nt = K / BK;
    unsigned voffA[2], voffB[2];
#pragma unroll
    for (int i = 0; i < 2; ++i) { int R, C; stage_rc(tid * 16 + i * 8192, R, C); const int Rb = Epi::PERM == 3 ? (64 * (R >> 5) + (R & 31)) : Epi::PERM == 2 ? (64 * (R >> 5) + perm32(R & 31)) : Epi::PERM ? ((R & ~31) + perm32(R & 31)) : R;
        voffA[i] = (unsigned)(R * g.ld + C) * 2u; voffB[i] = (unsigned)(Rb * g.ld + C) * 2u; }
    const size_t kstep = (size_t)(BK * 2);
    const size_t hstep = (size_t)HALF * g.ld * 2;
    const size_t tstep = 2 * hstep;
    const size_t hstepB = Epi::PERM >= 2 ? (size_t)32 * g.ld * 2 : hstep;
    const unsigned ldsw = (unsigned)wid * 1024u;
    const int aoff = lds_byte(wr * 64 + fr, fq * 8), boff = lds_byte(wc * 32 + fr, fq * 8);
#define PG8_SA(b, h) (((b) * 2 + (h)) * HTB)
#define PG8_SB(b, h) ((4 + (b) * 2 + (h)) * HTB)
#define PG8_STAGE(bufoff, gbase, voff) do { _Pragma("unroll") for (int _i = 0; _i < 2; ++_i) \
        __builtin_amdgcn_global_load_lds((const unsigned*)((const char*)(gbase) + (voff)[_i]), (LAS unsigned*)(lds + (bufoff) + ldsw + _i * 8192), 16, 0, 0); } while (0)
#define PG8_LDA(dst, b, h) do { _Pragma("unroll") for (int m = 0; m < 4; ++m) _Pragma("unroll") for (int k = 0; k < 2; ++k) dst[m][k] = *(const LAS bf16x8*)(lds + PG8_SA(b, h) + aoff + m * 2048 + k * 1024); } while (0)
#define PG8_LDB(dst, b, h) do { _Pragma("unroll") for (int n = 0; n < 2; ++n) _Pragma("unroll") for (int k = 0; k < 2; ++k) dst[n][k] = *(const LAS bf16x8*)(lds + PG8_SB(b, h) + boff + n * 2048 + k * 1024); } while (0)
#define PG8_MMA(ai, bj, At, Bt) do { __builtin_amdgcn_s_setprio(1); _Pragma("unroll") for (int m = 0; m < 4; ++m) _Pragma("unroll") for (int n = 0; n < 2; ++n) _Pragma("unroll") for (int k = 0; k < 2; ++k) \
        acc[ai][bj][m][n] = __builtin_amdgcn_mfma_f32_16x16x32_bf16(Bt[n][k], At[m][k], acc[ai][bj][m][n], 0, 0, 0); __builtin_amdgcn_s_setprio(0); } while (0)
#define PG8_WAIT_V(n) asm volatile("s_waitcnt vmcnt(" #n ")" ::: "memory")
#define PG8_WAIT_L(n) asm volatile("s_waitcnt lgkmcnt(" #n ")" ::: "memory")
#define PG8_BAR __builtin_amdgcn_s_barrier()
#define PG8_SCHED __builtin_amdgcn_sched_barrier(0)
    Unit cur, nxt; int ui = 0;
    if (!S.next(0, cur)) return;
    f32x4 acc[2][2][4][2];
#pragma unroll
    for (int a = 0; a < 2; ++a)
#pragma unroll
        for (int b = 0; b < 2; ++b)
#pragma unroll
            for (int m = 0; m < 4; ++m)
#pragma unroll
                for (int n = 0; n < 2; ++n) acc[a][b][m][n] = (f32x4){0.f, 0.f, 0.f, 0.f};
    bf16x8 At[4][2], B0[2][2], B1[2][2];
    const char* cA = (const char*)g.A + (size_t)cur.pm * tstep; const char* cB = (const char*)g.Bt + (size_t)cur.pn * tstep;
    S.a_ready(cur);
    PG8_STAGE(PG8_SB(0, 0), cB, voffB); PG8_STAGE(PG8_SA(0, 0), cA, voffA); PG8_STAGE(PG8_SB(0, 1), cB + hstepB, voffB); PG8_STAGE(PG8_SA(0, 1), cA + hstep, voffA);
    if (wr == 1) PG8_BAR;
    PG8_WAIT_V(4); PG8_BAR;
    PG8_STAGE(PG8_SB(1, 0), cB + kstep, voffB); PG8_STAGE(PG8_SA(1, 0), cA + kstep, voffA); PG8_STAGE(PG8_SB(1, 1), cB + hstepB + kstep, voffB);
    PG8_WAIT_V(6); PG8_BAR;
    for (;;) {
        const bool has_next = S.next(ui + 1, nxt);
        const char* nA = has_next ? (const char*)g.A + (size_t)nxt.pm * tstep : cA; const char* nB = has_next ? (const char*)g.Bt + (size_t)nxt.pn * tstep : cB;
        for (int t = 0; t < nt; t += 2) {
            const bool last = (t == nt - 2);
            const char* a1 = cA + (size_t)(t + 1) * kstep;
            const char* a2 = last ? nA : cA + (size_t)(t + 2) * kstep; const char* b2 = last ? nB : cB + (size_t)(t + 2) * kstep;
            const char* a3 = a2 + kstep; const char* b3 = b2 + kstep;
            if (last && has_next) S.a_ready(nxt);
            PG8_LDB(B0, 0, 0); PG8_SCHED; PG8_LDA(At, 0, 0); PG8_STAGE(PG8_SA(1, 1), a1 + hstep, voffA);
            PG8_WAIT_L(8); PG8_BAR; PG8_WAIT_L(0); PG8_MMA(0, 0, At, B0); PG8_BAR; PG8_SCHED;
            PG8_LDB(B1, 0, 1); PG8_STAGE(PG8_SB(0, 0), b2, voffB);
            PG8_BAR; PG8_WAIT_L(0); PG8_MMA(0, 1, At, B1); PG8_BAR;
            PG8_LDA(At, 0, 1); PG8_STAGE(PG8_SA(0, 0), a2, voffA);
            PG8_BAR; PG8_WAIT_L(0); PG8_MMA(1, 0, At, B0); PG8_BAR; PG8_SCHED;
            PG8_STAGE(PG8_SB(0, 1), b2 + hstepB, voffB);
            PG8_WAIT_V(6); PG8_BAR; PG8_MMA(1, 1, At, B1); PG8_BAR;
            PG8_LDB(B0, 1, 0); PG8_SCHED; PG8_LDA(At, 1, 0); PG8_STAGE(PG8_SA(0, 1), a2 + hstep, voffA);
            PG8_WAIT_L(8); PG8_BAR; PG8_WAIT_L(0); PG8_MMA(0, 0, At, B0); PG8_BAR; PG8_SCHED;
            PG8_LDB(B1, 1, 1); PG8_STAGE(PG8_SB(1, 0), b3, voffB);
            PG8_BAR; PG8_WAIT_L(0); PG8_MMA(0, 1, At, B1); PG8_BAR;
            PG8_LDA(At, 1, 1); PG8_STAGE(PG8_SA(1, 0), a3, voffA);
            PG8_BAR; PG8_WAIT_L(0); PG8_MMA(1, 0, At, B0); PG8_BAR; PG8_SCHED;
            PG8_STAGE(PG8_SB(1, 1), b3 + hstepB, voffB);
            PG8_WAIT_V(6); PG8_BAR; PG8_MMA(1, 1, At, B1); PG8_BAR;
        }
        E(acc, cur, wr, wc, fr, fq); S.done(cur);
        if (!has_next) break;
#pragma unroll
        for (int a = 0; a < 2; ++a)
#pragma unroll
            for (int b = 0; b < 2; ++b)
#pragma unroll
                for (int m = 0; m < 4; ++m)
#pragma unroll
                    for (int n = 0; n < 2; ++n) acc[a][b][m][n] = (f32x4){0.f, 0.f, 0.f, 0.f};
        cur = nxt; cA = nA; cB = nB; ++ui;
    }
    PG8_WAIT_V(0);
    if (wr == 0) PG8_BAR;
    PG8_BAR;
#undef PG8_SA
#undef PG8_SB
#undef PG8_STAGE
#undef PG8_LDA
#undef PG8_LDB
#undef PG8_MMA
#undef PG8_WAIT_V
#undef PG8_WAIT_L
#undef PG8_BAR
#undef PG8_SCHED
}
}

struct Args {
    const float* in[17];
    float* out;
    unsigned char* ws;
    int ph_lo, ph_hi;
    int wid, pad;
};
enum { I_X = 0, I_C, I_POS, I_WADA, I_BADA, I_N1G, I_WIN, I_BF, I_GNG, I_FNG, I_WOUT, I_N2G, I_WPQ, I_SK, I_U, I_V, I_FG };

DI void p0_mod(const Args& a, LAS unsigned char* lds) {
    const int tid = a.wid * 64 + lane_id();
    const float* c = a.in[I_C]; const float* w = a.in[I_WADA]; const float* bb = a.in[I_BADA];
    float* mod = (float*)(a.ws + WS_MOD);
    LAS float* red = (LAS float*)lds;
    for (int s = blockIdx.x; s < 256; s += gridDim.x) {
        const int cq = tid % 24, rg = tid / 24;
        f32x4 acc = {0.f, 0.f, 0.f, 0.f};
        if (tid < 504) {
            const float* wp = w + (size_t)rg * 24576 + s * 96 + cq * 4;
#pragma unroll 8
            for (int r = rg; r < 4096; r += 21) { const float sv = silu_f(c[r]); const f32x4 wv = *(const f32x4*)wp; acc += sv * wv; wp += (size_t)21 * 24576; }
            *(LAS f32x4*)(red + rg * 96 + cq * 4) = acc;
        }
        __syncthreads();
        if (tid < 96) { float sum = bb[s * 96 + tid];
            for (int r = 0; r < 21; ++r) sum += red[r * 96 + tid];
            mod[s * 96 + tid] = sum; }
        __syncthreads();
    }
}
DI void transpose_f32_to_bf16(const Args& a, const float* src, int K, int N, bf16_t* dst, LAS unsigned char* lds, int start, int qkperm = 0) {
    const int tid = a.wid * 64 + lane_id(); LAS float* tile = (LAS float*)lds;
    const int ntk = K / 64, ntn = (N + 63) / 64, ntiles = ntk * ntn;
    for (int ti = (blockIdx.x + start) % gridDim.x; ti < ntiles; ti += gridDim.x) {
        const int tk = ti % ntk, tn = ti / ntk; const int k0 = tk * 64, n0 = tn * 64;
#pragma unroll
        for (int u = 0; u < 2; ++u) { const int kr = (tid >> 4) + 32 * u, nc = (tid & 15) * 4;
            f32x4 v = {0.f, 0.f, 0.f, 0.f};
            if (n0 + nc < N) v = *(const f32x4*)(src + (size_t)(k0 + kr) * N + n0 + nc);
            tile[kr * 65 + nc] = v[0]; tile[kr * 65 + nc + 1] = v[1]; tile[kr * 65 + nc + 2] = v[2]; tile[kr * 65 + nc + 3] = v[3]; }
        __syncthreads();
        { const int n = tid >> 3, kc = (tid & 7) * 8;
          if (n0 + n < N) { float f[8];
#pragma unroll
              for (int j = 0; j < 8; ++j) f[j] = tile[(kc + j) * 65 + n];
              u32x4 w = {pk_bf16(f[0], f[1]), pk_bf16(f[2], f[3]), pk_bf16(f[4], f[5]), pk_bf16(f[6], f[7])};
              int nd = n0 + n; if (nd < qkperm) nd = (nd & ~127) | (((nd & 63) << 1) | ((nd >> 6) & 1));
              __builtin_nontemporal_store(w, (u32x4*)(dst + (size_t)nd * LDK + k0 + kc)); } }
        __syncthreads();
    }
}
DI void convert_f32_to_bf16(const Args& a, const float* src, bf16_t* dst, size_t n) {
    const size_t stride = (size_t)gridDim.x * NTHREADS * 8; const int tid = a.wid * 64 + lane_id();
    for (size_t i = ((size_t)blockIdx.x * NTHREADS + tid) * 8; i < n; i += stride) {
        const f32x4 v0 = *(const f32x4*)(src + i), v1 = *(const f32x4*)(src + i + 4);
        u32x4 w = {pk_bf16(v0[0], v0[1]), pk_bf16(v0[2], v0[3]), pk_bf16(v1[0], v1[1]), pk_bf16(v1[2], v1[3])};
        *(u32x4*)(dst + i) = w;
    }
}
template <int ULAYOUT> DI void quant_rows_i4(const Args& a, const float* src, unsigned char* dst, float* scale) {
    const int wid = a.wid, lane = lane_id(), stride = gridDim.x * 8;
    int row = blockIdx.x * 8 + wid;
    f32x4 nx[16];
    { const float* xr = src + (size_t)(row < 16384 ? row : 16383) * 4096;
#pragma unroll
      for (int c = 0; c < 16; ++c) nx[c] = *(const f32x4*)(xr + c * 256 + lane * 4); }
#pragma unroll 1
    for (; row < 16384; row += stride) {
        f32x4 v[16]; float mx = 0.f;
#pragma unroll
        for (int c = 0; c < 16; ++c) { v[c] = nx[c]; mx = fmaxf(fmaxf(mx, fmaxf(fabsf(v[c][0]), fabsf(v[c][1]))), fmaxf(fabsf(v[c][2]), fabsf(v[c][3]))); }
        { const int rn = row + stride < 16384 ? row + stride : 16383; const float* xr = src + (size_t)rn * 4096;
#pragma unroll
          for (int c = 0; c < 16; ++c) nx[c] = *(const f32x4*)(xr + c * 256 + lane * 4); }
        __builtin_amdgcn_sched_barrier(0);
#pragma unroll
        for (int m = 32; m >= 1; m >>= 1) mx = fmaxf(mx, __shfl_xor(mx, m));
        float bestr = 1.f, beste = 3.0e38f;
#pragma unroll 1
        for (int ci = 0; ci < 6; ++ci) {
            const float r = 1.f - 0.09f * (float)ci, sc = mx * r * (1.f / 7.f), isc = sc > 0.f ? 1.f / sc : 0.f;
            float e = 0.f;
#pragma unroll
            for (int c = 0; c < 8; ++c) { const float x = v[2 * c][c & 3]; const float t = __builtin_amdgcn_fmed3f(x * isc, -7.f, 7.f); const float q = (t + 12582912.f) - 12582912.f; const float d = x - q * sc; e = fmaf(d, d, e); }
#pragma unroll
            for (int m = 32; m >= 1; m >>= 1) e += __shfl_xor(e, m);
            if (e < beste) { beste = e; bestr = r; }
        }
        mx *= bestr;
        const float inv = mx > 0.f ? 7.f / mx : 0.f;
        unsigned qk[16];
#pragma unroll
        for (int c = 0; c < 16; ++c) {
            const unsigned u0 = __float_as_uint(__builtin_amdgcn_fmed3f(v[c][0] * inv, -7.f, 7.f) + 12582920.f), u1 = __float_as_uint(__builtin_amdgcn_fmed3f(v[c][1] * inv, -7.f, 7.f) + 12582920.f);
            const unsigned u2 = __float_as_uint(__builtin_amdgcn_fmed3f(v[c][2] * inv, -7.f, 7.f) + 12582920.f), u3 = __float_as_uint(__builtin_amdgcn_fmed3f(v[c][3] * inv, -7.f, 7.f) + 12582920.f);
            const unsigned p01 = __builtin_amdgcn_perm(u1, u0, 0x0c0c0400u), p23 = __builtin_amdgcn_perm(u3, u2, 0x0c0c0400u);
            const unsigned pk = (p01 | (p23 << 16)) & 0x0F0F0F0Fu;
            if (ULAYOUT) qk[c] = pk;
            else { const unsigned other = __shfl_xor(pk, 32);
                if (lane < 32) *(unsigned*)(dst + (size_t)c * (16384 * 128) + (size_t)row * 128 + lane * 4) = pk | ((other ^ 0x08080808u) << 4); } }
        if (ULAYOUT) {
#pragma unroll
            for (int c = 0; c < 8; ++c) { const unsigned lo = qk[c] ^ 0x08080808u, hi = qk[c + 8] ^ 0x08080808u;
                *(unsigned*)(dst + (size_t)row * 2048 + c * 256 + lane * 4) = lo | (hi << 4); }
        }
        if (lane == 0) scale[row] = mx * (1.f / 7.f);
    }
}
DI void quant_rows_i8(const Args& a, const float* src, unsigned char* dst, float* scale, int bias, int slicemajor) {
    const int wid = a.wid, lane = lane_id(), tid = wid * 64 + lane;
    for (int row = blockIdx.x * 8 + wid; row < 16384; row += gridDim.x * 8) {
        const float* xr = src + (size_t)row * 4096;
        f32x4 v[16]; float mx = 0.f;
#pragma unroll
        for (int c = 0; c < 16; ++c) { v[c] = *(const f32x4*)(xr + c * 256 + lane * 4); mx = fmaxf(mx, fmaxf(fmaxf(fabsf(v[c][0]), fabsf(v[c][1])), fmaxf(fabsf(v[c][2]), fabsf(v[c][3])))); }
#pragma unroll
        for (int m = 32; m >= 1; m >>= 1) mx = fmaxf(mx, __shfl_xor(mx, m));
        const float inv = mx > 0.f ? 127.f / mx : 0.f;
        unsigned* dr = (unsigned*)(dst + (size_t)row * 4096);
#pragma unroll
        for (int c = 0; c < 16; ++c) {
            const int q0 = (int)rintf(v[c][0] * inv) + bias, q1 = (int)rintf(v[c][1] * inv) + bias, q2 = (int)rintf(v[c][2] * inv) + bias, q3 = (int)rintf(v[c][3] * inv) + bias;
            const unsigned pk = (unsigned)(q0 & 255) | ((unsigned)(q1 & 255) << 8) | ((unsigned)(q2 & 255) << 16) | ((unsigned)(q3 & 255) << 24);
            if (slicemajor) *(unsigned*)(dst + (size_t)(2 * c + (lane >> 5)) * (16384 * 128) + (size_t)row * 128 + (lane & 31) * 4) = pk;
            else dr[c * 64 + lane] = pk; }
        if (lane == 0) scale[row] = mx * (1.f / 127.f);
    }
}
DI void phase_prologue(const Args& a, LAS unsigned char* lds) {
    p0_mod(a, lds);
    { const int* pos = (const int*)a.in[I_POS]; float* ct = (float*)(a.ws + WS_COS); float* st = (float*)(a.ws + WS_SIN);
      for (int i = blockIdx.x * NTHREADS + a.wid * 64 + lane_id(); i < T * 64; i += gridDim.x * NTHREADS) {
          const int t = i >> 6, f = i & 63;
          const double inv = exp(-(double)f * (9.210340371976184 / 64.0));
          const double ang = (double)pos[t] * inv;
          ct[i] = (float)cos(ang); st[i] = (float)sin(ang); } }
    transpose_f32_to_bf16(a, a.in[I_WIN], 4096, INW, (bf16_t*)(a.ws + WS_WIN), lds, 0, 2048);
    transpose_f32_to_bf16(a, a.in[I_WOUT], 4096, 4096, (bf16_t*)(a.ws + WS_WOUT), lds, 64);
    transpose_f32_to_bf16(a, a.in[I_WPQ], 4096, 2048, (bf16_t*)(a.ws + WS_WPQ), lds, 64);
    convert_f32_to_bf16(a, a.in[I_SK], (bf16_t*)(a.ws + WS_SKB), (size_t)8 * 2 * 128 * 128);
    quant_rows_i4<1>(a, a.in[I_U], a.ws + WS_UB, (float*)(a.ws + WS_SU));
    quant_rows_i4<0>(a, a.in[I_V], a.ws + WS_VB, (float*)(a.ws + WS_SV));
}

DI void phase_ff(const Args& a, LAS unsigned char* lds) {
    const int wid = a.wid, lane = lane_id(), r16 = lane & 15, kg = lane >> 4;
    const bf16_t* h1 = (const bf16_t*)(a.ws + WS_H1); const bf16_t* wf = (const bf16_t*)(a.ws + WS_WIN) + (size_t)NPAD * LDK;
    float* ffo = (float*)(a.ws + WS_FF);
    LAS float* red = (LAS float*)lds;
    for (int it = blockIdx.x; it < T / 64; it += gridDim.x) {
        const int sub = wid & 3, kh = wid >> 2;
        const bf16_t* ap = h1 + (size_t)(it * 64 + sub * 16 + r16) * LDK + kh * 2048 + kg * 8;
        const bf16_t* bp = wf + (size_t)r16 * LDK + kh * 2048 + kg * 8;
        f32x4 acc = {0.f, 0.f, 0.f, 0.f};
#pragma unroll 8
        for (int s = 0; s < 64; ++s) acc = __builtin_amdgcn_mfma_f32_16x16x32_bf16(*(const bf16x8*)(ap + s * 32), *(const bf16x8*)(bp + s * 32), acc, 0, 0, 0);
        if (kh == 1) {
#pragma unroll
            for (int i = 0; i < 4; ++i) red[(sub * 16 + 4 * kg + i) * 16 + r16] = acc[i]; }
        __syncthreads();
        if (kh == 0) {
#pragma unroll
            for (int i = 0; i < 4; ++i) ffo[(size_t)(it * 64 + sub * 16 + 4 * kg + i) * 16 + r16] = acc[i] + red[(sub * 16 + 4 * kg + i) * 16 + r16]; }
        __syncthreads();
    }
}

DI void phase_norm_mod_bf(const Args& a, const bf16_t* x, const float* g, const float* shift, const float* scale, bf16_t* dst, LAS unsigned char* lds) {
    const int wid = a.wid, lane = lane_id(), tid = wid * 64 + lane;
    LAS float* A1 = (LAS float*)lds; LAS float* B1 = A1 + 4096;
    for (int i = tid; i < 4096; i += NTHREADS) { A1[i] = g[i] * (1.f + scale[i]); B1[i] = shift[i]; }
    __syncthreads();
    for (int row = blockIdx.x * 8 + wid; row < T; row += gridDim.x * 8) {
        const bf16_t* xr = x + (size_t)row * X1P;
        u32x4 v[8]; float ss = 0.f;
#pragma unroll
        for (int c = 0; c < 8; ++c) { v[c] = *(const u32x4*)(xr + c * 512 + lane * 8);
#pragma unroll
            for (int w = 0; w < 4; ++w) { const float lo = bf_lo(v[c][w]), hi = bf_hi(v[c][w]); ss += lo * lo + hi * hi; } }
        ss = wave_sum(ss);
        const float rs = rsqrtf(ss * (1.f / 4096.f) + EPS);
        bf16_t* dr = dst + (size_t)row * LDK;
#pragma unroll
        for (int c = 0; c < 8; ++c) { const int col = c * 512 + lane * 8;
            const f32x4 a0 = *(const LAS f32x4*)(A1 + col), a1 = *(const LAS f32x4*)(A1 + col + 4), b0 = *(const LAS f32x4*)(B1 + col), b1 = *(const LAS f32x4*)(B1 + col + 4);
            u32x4 w;
            w[0] = pk_bf16(bf_lo(v[c][0]) * rs * a0[0] + b0[0], bf_hi(v[c][0]) * rs * a0[1] + b0[1]); w[1] = pk_bf16(bf_lo(v[c][1]) * rs * a0[2] + b0[2], bf_hi(v[c][1]) * rs * a0[3] + b0[3]);
            w[2] = pk_bf16(bf_lo(v[c][2]) * rs * a1[0] + b1[0], bf_hi(v[c][2]) * rs * a1[1] + b1[1]); w[3] = pk_bf16(bf_lo(v[c][3]) * rs * a1[2] + b1[2], bf_hi(v[c][3]) * rs * a1[3] + b1[3]);
            *(u32x4*)(dr + col) = w; }
    }
    __syncthreads();
}
DI void phase_norm_mod(const Args& a, const float* x, const float* g, const float* shift, const float* scale, bf16_t* dst, LAS unsigned char* lds) {
    const int wid = a.wid, lane = lane_id(), tid = wid * 64 + lane;
    LAS float* A1 = (LAS float*)lds; LAS float* B1 = A1 + 4096;
    for (int i = tid; i < 4096; i += NTHREADS) { A1[i] = g[i] * (1.f + scale[i]); B1[i] = shift[i]; }
    __syncthreads();
    for (int row = blockIdx.x * 8 + wid; row < T; row += gridDim.x * 8) {
        const float* xr = x + (size_t)row * D;
        f32x4 v[16]; float ss = 0.f;
#pragma unroll
        for (int c = 0; c < 16; ++c) { v[c] = *(const f32x4*)(xr + c * 256 + lane * 4); ss += v[c][0] * v[c][0] + v[c][1] * v[c][1] + v[c][2] * v[c][2] + v[c][3] * v[c][3]; }
        ss = wave_sum(ss);
        const float rs = rsqrtf(ss * (1.f / 4096.f) + EPS);
        bf16_t* dr = dst + (size_t)row * LDK;
#pragma unroll
        for (int c = 0; c < 16; ++c) { const int col = c * 256 + lane * 4;
            const f32x4 aa = *(const LAS f32x4*)(A1 + col), bb = *(const LAS f32x4*)(B1 + col);
            const f32x4 y = v[c] * rs * aa + bb;
            u32x2 w = {pk_bf16(y[0], y[1]), pk_bf16(y[2], y[3])};
            *(u32x2*)(dr + col) = w; }
    }
    __syncthreads();
}

template <bool IS_K>
DI void rotary_tile(const Args& a, int pt, int h, LAS unsigned char* lds) {
    const int tid = a.wid * 64 + lane_id();
    const bf16_t* proj = (const bf16_t*)(a.ws + WS_PROJ);
    const float* ct = (const float*)(a.ws + WS_COS); const float* st = (const float*)(a.ws + WS_SIN);
    const int pos = tid >> 3, dq = tid & 7; const int t = pt * 64 + pos;
    const bf16_t* src = proj + (size_t)t * NPAD + (IS_K ? C_RK : C_RQ) + h * 128 + dq * 8;
    const u32x4 x1 = *(const u32x4*)src, x2 = *(const u32x4*)(src + 64);
    const f32x4 c0 = *(const f32x4*)(ct + (size_t)t * 64 + dq * 8), c1 = *(const f32x4*)(ct + (size_t)t * 64 + dq * 8 + 4);
    const f32x4 s0 = *(const f32x4*)(st + (size_t)t * 64 + dq * 8), s1 = *(const f32x4*)(st + (size_t)t * 64 + dq * 8 + 4);
    float cs[8] = {c0[0], c0[1], c0[2], c0[3], c1[0], c1[1], c1[2], c1[3]}, sn[8] = {s0[0], s0[1], s0[2], s0[3], s1[0], s1[1], s1[2], s1[3]};
    float o1[8], o2[8];
    const float sc = IS_K ? 0.08838834764831845f : 1.0f;
#pragma unroll
    for (int j = 0; j < 8; ++j) { const unsigned w1 = x1[j >> 1], w2 = x2[j >> 1];
        const float a1 = (j & 1) ? bf_hi(w1) : bf_lo(w1), a2 = (j & 1) ? bf_hi(w2) : bf_lo(w2);
        o1[j] = (a1 * cs[j] - a2 * sn[j]) * sc; o2[j] = (a1 * sn[j] + a2 * cs[j]) * sc; }
    bf16_t* dn = (bf16_t*)(a.ws + (IS_K ? WS_RK : WS_RQ)) + (size_t)t * 1024 + h * 128 + dq * 8;
    *(u32x4*)dn = (u32x4){pk_bf16(o1[0], o1[1]), pk_bf16(o1[2], o1[3]), pk_bf16(o1[4], o1[5]), pk_bf16(o1[6], o1[7])};
    *(u32x4*)(dn + 64) = (u32x4){pk_bf16(o2[0], o2[1]), pk_bf16(o2[2], o2[3]), pk_bf16(o2[4], o2[5]), pk_bf16(o2[6], o2[7])};
    if constexpr (IS_K) {
        LAS bf16_t* tl = (LAS bf16_t*)lds;
        const float lg = log1pf(-exp2f(-5.f - (float)h));
        const float dec = __expf((float)(127 - (t & 127)) * lg);
#pragma unroll
        for (int j = 0; j < 8; ++j) { tl[(dq * 8 + j) * 66 + pos] = f2bf(o1[j] * dec); tl[(64 + dq * 8 + j) * 66 + pos] = f2bf(o2[j] * dec); }
        __syncthreads();
        { const int d = tid >> 2, pc = (tid & 3) * 16;
          LAS const unsigned* rp = (LAS const unsigned*)(tl + d * 66 + pc);
          u32x4 w0 = {rp[0], rp[1], rp[2], rp[3]}, w1 = {rp[4], rp[5], rp[6], rp[7]};
          bf16_t* dt = (bf16_t*)(a.ws + WS_RKT) + (size_t)(h * 128 + d) * T + pt * 64 + pc;
          *(u32x4*)dt = w0; *(u32x4*)(dt + 8) = w1; }
        __syncthreads();
    }
}
DI void transpose_bf16_tile(const Args& a, const bf16_t* proj, int col0, bf16_t* dst, int pt, int ctile, LAS unsigned char* lds) {
    const int tid = a.wid * 64 + lane_id(); LAS bf16_t* tl = (LAS bf16_t*)lds;
    { const int pos = tid >> 3, cc = (tid & 7) * 8;
      const u32x4 v = *(const u32x4*)(proj + (size_t)(pt * 64 + pos) * NPAD + col0 + ctile * 64 + cc);
      LAS unsigned* wp = (LAS unsigned*)(tl + pos * 72 + cc); wp[0] = v[0]; wp[1] = v[1]; wp[2] = v[2]; wp[3] = v[3]; }
    __syncthreads();
    { const int c = tid >> 3, pc = (tid & 7) * 8; unsigned short e[8];
#pragma unroll
      for (int j = 0; j < 8; ++j) e[j] = tl[(pc + j) * 72 + c];
      u32x4 w = {(unsigned)e[0] | ((unsigned)e[1] << 16), (unsigned)e[2] | ((unsigned)e[3] << 16), (unsigned)e[4] | ((unsigned)e[5] << 16), (unsigned)e[6] | ((unsigned)e[7] << 16)};
      *(u32x4*)(dst + (size_t)(ctile * 64 + c) * T + pt * 64 + pc) = w; }
    __syncthreads();
}
DI void cumsum_head(const Args& a, int h, LAS unsigned char* lds) {
    const int tid = a.wid * 64 + lane_id();
    const bf16_t* proj = (const bf16_t*)(a.ws + WS_PROJ);
    float* cum = (float*)(a.ws + WS_CUM) + (size_t)h * T; const float* ffl = (const float*)(a.ws + WS_FF);
    const float bf = a.in[I_BF][h];
    LAS double* part = (LAS double*)lds;
    float lf[32];
#pragma unroll
    for (int j = 0; j < 32; ++j) { const float f = ffl[(size_t)(tid * 32 + j) * 16 + h] + bf;
        lf[j] = fminf(f, 0.f) - log1pf(__expf(-fabsf(f))); }
    double s = 0.0;
#pragma unroll
    for (int j = 0; j < 32; ++j) s += (double)lf[j];
    part[tid] = s;
    __syncthreads();
    LAS double* pa = part; LAS double* pb = part + NTHREADS;
#pragma unroll 1
    for (int off = 1; off < NTHREADS; off <<= 1) { const double v = pa[tid] + (tid >= off ? pa[tid - off] : 0.0); pb[tid] = v; __syncthreads(); LAS double* t = pa; pa = pb; pb = t; }
    double run = pa[tid] - s;
#pragma unroll
    for (int j = 0; j < 32; ++j) { run += (double)lf[j]; cum[tid * 32 + j] = (float)run; }
    __syncthreads();
}
DI void knorm_item(const Args& a, int item, LAS unsigned char* lds) {
    const int tid = a.wid * 64 + lane_id();
    const bf16_t* proj = (const bf16_t*)(a.ws + WS_PROJ);
    LAS unsigned* smax = (LAS unsigned*)lds;
    if (tid < 16) smax[tid] = 0u;
    __syncthreads();
    const int pos = item * 32 + (tid >> 4), h = tid & 15;
    const bf16_t* kp = proj + (size_t)pos * NPAD + C_FK + h * 128;
    float n2 = 0.f;
#pragma unroll
    for (int c = 0; c < 16; ++c) { const u32x4 w = *(const u32x4*)(kp + c * 8);
#pragma unroll
        for (int j = 0; j < 4; ++j) { const float lo = bf_lo(w[j]), hi = bf_hi(w[j]); n2 += lo * lo + hi * hi; } }
    n2 = fmaxf(n2, __shfl_xor(n2, 16)); n2 = fmaxf(n2, __shfl_xor(n2, 32));
    if ((tid & 63) < 16) (void)__hip_atomic_fetch_max(smax + h, __float_as_uint(n2), __ATOMIC_RELAXED, __HIP_MEMORY_SCOPE_WORKGROUP);
    __syncthreads();
    if (tid < 16) (void)__hip_atomic_fetch_max((unsigned*)(a.ws + WS_CTL) + CW_KMAX + tid, smax[tid], __ATOMIC_RELAXED, __HIP_MEMORY_SCOPE_AGENT);
    __syncthreads();
}
DI void phase_prep(const Args& a, LAS unsigned char* lds) {
    const bf16_t* proj = (const bf16_t*)(a.ws + WS_PROJ);
    for (int it = blockIdx.x; it < 16 + 512; it += gridDim.x) {
        if (it >= 16) knorm_item(a, it - 16, lds);
        else cumsum_head(a, it, lds);
    }
}

constexpr int RO_S = 4096, RO_K = RO_S + 256 * 272;
DI void phase_ret_kv(const Args& a, LAS unsigned char* lds) {
    const int wid = a.wid, lane = lane_id(), tid = wid * 64 + lane, r = lane & 31, hh = lane >> 5;
    const bf16_t* rvt = (const bf16_t*)(a.ws + WS_RVT); const bf16_t* rkt = (const bf16_t*)(a.ws + WS_RKT);
    float* kv = (float*)(a.ws + WS_KV);
    u32x4 pv[8], pk[4];
#define RK_LOAD(u_) do { const int n_ = (u_) >> 3, h_ = (u_) & 7; \
        _Pragma("unroll") for (int it = 0; it < 8; ++it) { const int L = it * 512 + tid, row = L >> 4, pc = L & 15; pv[it] = *(const u32x4*)(rvt + (size_t)(h_ * 256 + row) * T + n_ * 128 + pc * 8); } \
        _Pragma("unroll") for (int it = 0; it < 4; ++it) { const int L = it * 512 + tid, row = L >> 4, pc = L & 15; pk[it] = *(const u32x4*)(rkt + (size_t)(h_ * 128 + row) * T + n_ * 128 + pc * 8); } } while (0)
    if ((int)blockIdx.x < 1024) RK_LOAD((int)blockIdx.x);
    for (int u = blockIdx.x; u < 1024; u += gridDim.x) {
        const int n = u >> 3, h = u & 7;
#pragma unroll
        for (int it = 0; it < 8; ++it) { const int L = it * 512 + tid, row = L >> 4, pc = L & 15; *(LAS u32x4*)(lds + RO_S + row * 272 + pc * 16) = pv[it]; }
#pragma unroll
        for (int it = 0; it < 4; ++it) { const int L = it * 512 + tid, row = L >> 4, pc = L & 15; *(LAS u32x4*)(lds + RO_K + row * 272 + pc * 16) = pk[it]; }
        __syncthreads();
        { const int un = u + (int)gridDim.x < 1024 ? u + (int)gridDim.x : u; RK_LOAD(un); }
        bf16x8 af[8];
#pragma unroll
        for (int s = 0; s < 8; ++s) af[s] = *(LAS const bf16x8*)(lds + RO_S + (wid * 32 + r) * 272 + hh * 16 + s * 32);
        f32x16 acc[4];
#pragma unroll
        for (int tn = 0; tn < 4; ++tn) {
#pragma unroll
            for (int i = 0; i < 16; ++i) acc[tn][i] = 0.f;
#pragma unroll
            for (int s = 0; s < 8; ++s) acc[tn] = MFMA32(af[s], *(LAS const bf16x8*)(lds + RO_K + (tn * 32 + r) * 272 + hh * 16 + s * 32), acc[tn]);
        }
        float* op = kv + ((size_t)(n * 8 + h) * 256 + wid * 32) * 128;
#pragma unroll
        for (int tn = 0; tn < 4; ++tn)
#pragma unroll
            for (int i = 0; i < 16; ++i) op[(size_t)crow(i, hh) * 128 + tn * 32 + r] = acc[tn][i];
        __syncthreads();
    }
#undef RK_LOAD
}
DI void ret_scan_item(const Args& a, int item) {
    float* kv = (float*)(a.ws + WS_KV);
    constexpr int PER = 8 * 256 * 128;
    const int h = item >> 3;
    const float dec = __expf(128.f * log1pf(-exp2f(-5.f - (float)h)));
    const int base = item * 4096 + a.wid * 64 + lane_id();
    float S[8];
#pragma unroll
    for (int e = 0; e < 8; ++e) S[e] = 0.f;
#pragma unroll 1
    for (int n0 = 0; n0 < 128; n0 += 4) {
        float v[4][8];
#pragma unroll
        for (int j = 0; j < 4; ++j)
#pragma unroll
            for (int e = 0; e < 8; ++e) v[j][e] = kv[(size_t)(n0 + j) * PER + base + e * 512];
#pragma unroll
        for (int j = 0; j < 4; ++j)
#pragma unroll
            for (int e = 0; e < 8; ++e) { kv[(size_t)(n0 + j) * PER + base + e * 512] = S[e]; S[e] = S[e] * dec + v[j][e]; }
    }
    asm volatile("s_waitcnt vmcnt(0)" ::: "memory");
    __syncthreads();
    if (a.wid == 0 && lane_id() == 0) {
        __builtin_amdgcn_fence(__ATOMIC_RELEASE, "agent");
        asm volatile("s_waitcnt vmcnt(0)" ::: "memory");
        (void)__hip_atomic_fetch_add((unsigned*)(a.ws + WS_CTL) + CW_SCAN + 64 * h, 1u, __ATOMIC_RELAXED, __HIP_MEMORY_SCOPE_AGENT);
    }
}
DI void ret_scan_wait(const Args& a, int h) {
    if (a.wid == 0 && lane_id() == 0) {
        unsigned* cnt = (unsigned*)(a.ws + WS_CTL) + CW_SCAN + 64 * h; unsigned sp = 0;
        while (__hip_atomic_load(cnt, __ATOMIC_RELAXED, __HIP_MEMORY_SCOPE_AGENT) < 8u) { __builtin_amdgcn_s_sleep(2); if (++sp > (1u << 26)) break; }
        __builtin_amdgcn_fence(__ATOMIC_ACQUIRE, "agent");
        asm volatile("s_waitcnt vmcnt(0)" ::: "memory");
    }
    __syncthreads();
}

DI void ret_out_unit(const Args& a, int n, int h, LAS unsigned char* lds) {
    const int wid = a.wid, lane = lane_id(), tid = wid * 64 + lane, r = lane & 31, hh = lane >> 5;
    const int qg = wid & 3, eh = wid >> 2;
    const bf16_t* rq = (const bf16_t*)(a.ws + WS_RQ); const bf16_t* rk = (const bf16_t*)(a.ws + WS_RK); const bf16_t* rvt = (const bf16_t*)(a.ws + WS_RVT);
    const float* st = (const float*)(a.ws + WS_KV) + (size_t)(n * 8 + h) * 256 * 128;
    const bf16_t* proj = (const bf16_t*)(a.ws + WS_PROJ);
    bf16_t* y = (bf16_t*)(a.ws + WS_H1);
    const int p0 = n * 128; const int il = qg * 32 + r;
    const float lg2 = log1pf(-exp2f(-5.f - (float)h)) * LOG2E;
#pragma unroll
    for (int it = 0; it < 8; ++it) { const int L = it * 512 + tid, row = L >> 4, dc = L & 15;
        const f32x4 f0 = *(const f32x4*)(st + (size_t)row * 128 + dc * 8), f1 = *(const f32x4*)(st + (size_t)row * 128 + dc * 8 + 4);
        *(LAS bf16x8*)(lds + RO_S + row * 272 + dc * 16) = pack8(f0[0], f0[1], f0[2], f0[3], f1[0], f1[1], f1[2], f1[3]); }
#pragma unroll
    for (int it = 0; it < 4; ++it) { const int L = it * 512 + tid, pos = L >> 4, dc = L & 15;
        *(LAS u32x4*)(lds + RO_K + pos * 272 + dc * 16) = *(const u32x4*)(rk + (size_t)(p0 + pos) * 1024 + h * 128 + dc * 8); }
    bf16x8 qf[8];
    { const bf16_t* qp = rq + (size_t)(p0 + il) * 1024 + h * 128 + hh * 8;
#pragma unroll
      for (int s = 0; s < 8; ++s) qf[s] = *(const bf16x8*)(qp + s * 16); }
    u32x4 vpre[8];
#pragma unroll
    for (int it = 0; it < 8; ++it) { const int L = it * 512 + tid, row = L >> 4, pc = L & 15;
        vpre[it] = *(const u32x4*)(rvt + (size_t)(h * 256 + row) * T + p0 + pc * 8); }
    __syncthreads();
    f32x16 O[4];
#pragma unroll
    for (int et = 0; et < 4; ++et) {
#pragma unroll
        for (int i = 0; i < 16; ++i) O[et][i] = 0.f;
        LAS const unsigned char* sp = lds + RO_S + (eh * 128 + et * 32 + r) * 272 + hh * 16;
#pragma unroll
        for (int s = 0; s < 8; ++s) O[et] = MFMA32(*(LAS const bf16x8*)(sp + s * 32), qf[s], O[et]);
    }
    { const float fq = exp2f((float)(il + 1) * lg2);
#pragma unroll
      for (int et = 0; et < 4; ++et)
#pragma unroll
          for (int i = 0; i < 16; ++i) O[et][i] *= fq; }
    __syncthreads();
#pragma unroll
    for (int it = 0; it < 8; ++it) { const int L = it * 512 + tid, row = L >> 4, pc = L & 15;
        *(LAS u32x4*)(lds + RO_S + row * 272 + pc * 16) = vpre[it]; }
    u32x4 gpre[8];
#pragma unroll
    for (int c = 0; c < 8; ++c) { const int chunk = c * 64 + lane; const int tr = chunk >> 4, ec = (chunk & 15) * 8;
        gpre[c] = *(const u32x4*)(proj + (size_t)(p0 + qg * 32 + tr) * NPAD + C_RG + h * 256 + eh * 128 + ec); }
    __syncthreads();
    for (int jt = 0; jt <= qg; ++jt) {
        f32x16 sc;
#pragma unroll
        for (int i = 0; i < 16; ++i) sc[i] = 0.f;
        LAS const unsigned char* kp = lds + RO_K + (jt * 32 + r) * 272 + hh * 16;
#pragma unroll
        for (int s = 0; s < 8; ++s) sc = MFMA32(*(LAS const bf16x8*)(kp + s * 32), qf[s], sc);
        float p[16];
#pragma unroll
        for (int i = 0; i < 16; ++i) { const int dj = il - (jt * 32 + crow(i, hh)); p[i] = dj >= 0 ? sc[i] * exp2f((float)dj * lg2) : 0.f; }
#pragma unroll
        for (int ks = 0; ks < 2; ++ks) {
            const bf16x8 pb = pack8(p[8 * ks], p[8 * ks + 1], p[8 * ks + 2], p[8 * ks + 3], p[8 * ks + 4], p[8 * ks + 5], p[8 * ks + 6], p[8 * ks + 7]);
#pragma unroll
            for (int et = 0; et < 4; ++et) {
                LAS const unsigned char* vp = lds + RO_S + (eh * 128 + et * 32 + r) * 272 + (jt * 32 + ks * 16 + hh * 4) * 2;
                const u32x2 lo = *(LAS const u32x2*)vp, hi = *(LAS const u32x2*)(vp + 16);
                const u32x4 w = {lo[0], lo[1], hi[0], hi[1]};
                O[et] = MFMA32(__builtin_bit_cast(bf16x8, w), pb, O[et]);
            }
        }
    }
    float s1 = 0.f, s2 = 0.f;
#pragma unroll
    for (int et = 0; et < 4; ++et)
#pragma unroll
        for (int i = 0; i < 16; ++i) { s1 += O[et][i]; s2 += O[et][i] * O[et][i]; }
    s1 = swap32_sum(s1); s2 = swap32_sum(s2);
    LAS float* ex = (LAS float*)lds;
    if (hh == 0) { ex[(wid * 32 + r) * 2] = s1; ex[(wid * 32 + r) * 2 + 1] = s2; }
    __syncthreads();
    s1 += ex[((wid ^ 4) * 32 + r) * 2]; s2 += ex[((wid ^ 4) * 32 + r) * 2 + 1];
    const float mu = s1 * (1.f / 256.f); const float var = fmaxf(s2 * (1.f / 256.f) - mu * mu, 0.f); const float rs = rsqrtf(var + EPS);
    const float* gg = a.in[I_GNG] + h * 256 + eh * 128;
    LAS unsigned char* tw = lds + 4096 + wid * (32 * 264);
#pragma unroll
    for (int et = 0; et < 4; ++et)
#pragma unroll
        for (int g4 = 0; g4 < 4; ++g4) { const int e0 = et * 32 + 8 * g4 + 4 * hh; const f32x4 gn = *(const f32x4*)(gg + e0);
            *(LAS u32x2*)(tw + r * 264 + e0 * 2) = (u32x2){pk_bf16((O[et][4 * g4] - mu) * rs * gn[0], (O[et][4 * g4 + 1] - mu) * rs * gn[1]), pk_bf16((O[et][4 * g4 + 2] - mu) * rs * gn[2], (O[et][4 * g4 + 3] - mu) * rs * gn[3])}; }
#pragma unroll
    for (int c = 0; c < 8; ++c) { const int chunk = c * 64 + lane; const int tr = chunk >> 4, ec = (chunk & 15) * 8;
        const int t = p0 + qg * 32 + tr;
        const u32x2 ya = *(LAS const u32x2*)(tw + tr * 264 + ec * 2), yb = *(LAS const u32x2*)(tw + tr * 264 + ec * 2 + 8);
        const u32x4 gw = gpre[c];
        u32x4 o;
        o[0] = pk_bf16(bf_lo(ya[0]) * silu_f(bf_lo(gw[0])), bf_hi(ya[0]) * silu_f(bf_hi(gw[0]))); o[1] = pk_bf16(bf_lo(ya[1]) * silu_f(bf_lo(gw[1])), bf_hi(ya[1]) * silu_f(bf_hi(gw[1])));
        o[2] = pk_bf16(bf_lo(yb[0]) * silu_f(bf_lo(gw[2])), bf_hi(yb[0]) * silu_f(bf_hi(gw[2]))); o[3] = pk_bf16(bf_lo(yb[1]) * silu_f(bf_lo(gw[3])), bf_hi(yb[1]) * silu_f(bf_hi(gw[3])));
        *(u32x4*)(y + (size_t)t * LDK + h * 256 + eh * 128 + ec) = o; }
    __syncthreads();
}

DI int at_k(int sl) { return sl == 0 ? 0 : sl == 1 ? 16384 : sl == 2 ? 67584 : 83968; }
DI int at_v(int sl) { return sl == 0 ? 32768 : sl == 1 ? 50176 : sl == 2 ? 100352 : 132096; }
DI int at_c(int sl) { return 117760 + sl * 256; }
constexpr int AT_END = 118784;
DI void attn_unit(const Args& a, int h, int qb, LAS unsigned char* lds) {
    const int wid = a.wid, lane = lane_id(), tid = wid * 64 + lane, r = lane & 31, hh = lane >> 5;
    const bf16_t* proj = (const bf16_t*)(a.ws + WS_PROJ); const bf16_t* fvt = (const bf16_t*)(a.ws + WS_FVT) + (size_t)h * 128 * T;
    const float* cum = (const float*)(a.ws + WS_CUM) + (size_t)h * T;
    bf16_t* y = (bf16_t*)(a.ws + WS_H1);
    const int I0 = qb * 256; const int irow = I0 + wid * 32 + r;
    constexpr float C2 = 0.08838834764831845f * LOG2E;
    const float cref = cum[I0];
    const float ci2 = (cum[irow] - cref) * LOG2E;
    bf16x8 qf[8];
    { const bf16_t* qp = proj + (size_t)irow * NPAD + C_FQ + h * 128 + hh * 8;
#pragma unroll
      for (int s = 0; s < 8; ++s) qf[s] = *(const bf16x8*)(qp + s * 16); }
    f32x16 O[4];
#pragma unroll
    for (int et = 0; et < 4; ++et)
#pragma unroll
        for (int i = 0; i < 16; ++i) O[et][i] = 0.f;
    float m = -1e30f, l = 0.f;
    const int nt = qb * 4 + 4;
    float Bi;
    { float q2 = 0.f;
#pragma unroll
      for (int s = 0; s < 8; ++s)
#pragma unroll
          for (int j = 0; j < 8; ++j) { const float x = bf2f((bf16_t)qf[s][j]); q2 += x * x; }
      q2 = swap32_sum(q2);
      const float kmax = sqrtf(__uint_as_float(((const unsigned*)(a.ws + WS_CTL))[CW_KMAX + h]));
      Bi = sqrtf(q2) * kmax * C2 * 1.0001f + ci2; }
    float thresh = 3.0e38f;
    u32x4 kreg[2], vreg[2]; float creg = 0.f;
    const bf16_t* kbase = proj + C_FK + h * 128;
#define AT_LOAD(kt) do { _Pragma("unroll") for (int u_ = 0; u_ < 2; ++u_) { const int c_ = tid + 512 * u_; \
        kreg[u_] = *(const u32x4*)(kbase + (size_t)((kt) * 64 + (c_ >> 4)) * NPAD + (c_ & 15) * 8); \
        vreg[u_] = *(const u32x4*)(fvt + (size_t)(c_ >> 3) * T + (kt) * 64 + (c_ & 7) * 8); } \
        if (tid < 64) creg = (cum[(kt) * 64 + tid] - cref) * LOG2E; } while (0)
#define AT_STORE(KOFF, VOFF, COFF) do { _Pragma("unroll") for (int u_ = 0; u_ < 2; ++u_) { const int c_ = tid + 512 * u_; const int key_ = c_ >> 4; \
        *(LAS u32x4*)(lds + (KOFF) + key_ * 256 + (((c_ & 15) * 16) ^ ((key_ & 7) << 4))) = kreg[u_]; \
        LAS unsigned char* vp_ = lds + (VOFF) + (c_ >> 3) * 136 + (c_ & 7) * 16; \
        *(LAS u32x2*)vp_ = (u32x2){vreg[u_][0], vreg[u_][1]}; *(LAS u32x2*)(vp_ + 8) = (u32x2){vreg[u_][2], vreg[u_][3]}; } \
        if (tid < 64) *(LAS float*)(lds + (COFF) + tid * 4) = creg; } while (0)
    AT_LOAD(nt - 1);
    AT_STORE(at_k(0), at_v(0), at_c(0));
    AT_LOAD(nt - 2);
    AT_STORE(at_k(1), at_v(1), at_c(1));
    __syncthreads();
    for (int it = 0; it < nt; ++it) {
        const int kt = nt - 1 - it;
        const int KO = at_k(it & 3), VO = at_v(it & 3), CO = at_c(it & 3);
        if (it >= 4) { if (*(LAS const float*)(lds + CO + 63 * 4) > thresh) break; }
        if (kt > 1) AT_LOAD(kt - 2);
        const int key0 = kt * 64;
        if (key0 <= I0 + wid * 32 + 31) {
            f32x16 st[2];
#pragma unroll
            for (int th = 0; th < 2; ++th) {
#pragma unroll
                for (int i = 0; i < 16; ++i) st[th][i] = 0.f;
                LAS const unsigned char* kp = lds + KO + (th * 32 + r) * 256;
#pragma unroll
                for (int s = 0; s < 8; ++s) { const bf16x8 kf = *(LAS const bf16x8*)(kp + ((s * 32 + hh * 16) ^ ((r & 7) << 4))); st[th] = MFMA32(kf, qf[s], st[th]); }
            }
            float tv[2][16]; float mx = -__builtin_inff();
            const bool diag = (key0 + 63 > I0 + wid * 32);
            if (diag) {
#pragma unroll
            for (int th = 0; th < 2; ++th)
#pragma unroll
                for (int g4 = 0; g4 < 4; ++g4) { const f32x4 cj = *(LAS const f32x4*)(lds + CO + (th * 32 + 8 * g4 + 4 * hh) * 4);
#pragma unroll
                    for (int q = 0; q < 4; ++q) { const int i = g4 * 4 + q; float tt = fmaf(st[th][i], C2, -cj[q]);
                        const int kj = key0 + th * 32 + 8 * g4 + 4 * hh + q; tt = (kj <= irow) ? tt : -__builtin_inff();
                        tv[th][i] = tt; mx = fmaxf(mx, tt); } }
            } else {
#pragma unroll
            for (int th = 0; th < 2; ++th)
#pragma unroll
                for (int g4 = 0; g4 < 4; ++g4) { const f32x4 cj = *(LAS const f32x4*)(lds + CO + (th * 32 + 8 * g4 + 4 * hh) * 4);
#pragma unroll
                    for (int q = 0; q < 4; ++q) { const int i = g4 * 4 + q; const float tt = fmaf(st[th][i], C2, -cj[q]);
                        tv[th][i] = tt; mx = fmaxf(mx, tt); } }
            }
            asm volatile("" ::: "memory");
            mx = swap32_max(mx) + ci2;
            if (!__all(mx < m - 40.f)) {
            const float mn = fmaxf(m, mx);
            if (!__all(mx <= m)) {
                const float alpha = __builtin_amdgcn_exp2f(m - mn); l *= alpha;
#pragma unroll
                for (int et = 0; et < 4; ++et)
#pragma unroll
                    for (int i = 0; i < 16; ++i) O[et][i] *= alpha;
            }
            m = mn;
            const float off = ci2 - mn; float ps = 0.f;
#pragma unroll
            for (int th = 0; th < 2; ++th)
#pragma unroll
                for (int i = 0; i < 16; ++i) { tv[th][i] = __builtin_amdgcn_exp2f(tv[th][i] + off); ps += tv[th][i]; }
            ps = swap32_sum(ps);
            l += ps;
#pragma unroll
            for (int ks = 0; ks < 4; ++ks) {
                const int th = ks >> 1, b = (ks & 1) * 8;
                const bf16x8 pb = pack8(tv[th][b], tv[th][b + 1], tv[th][b + 2], tv[th][b + 3], tv[th][b + 4], tv[th][b + 5], tv[th][b + 6], tv[th][b + 7]);
#pragma unroll
                for (int et = 0; et < 4; ++et) {
                    LAS const unsigned char* vp = lds + VO + (et * 32 + r) * 136 + (ks * 16 + hh * 4) * 2;
                    const u32x2 lo = *(LAS const u32x2*)vp, hi = *(LAS const u32x2*)(vp + 16);
                    const u32x4 w = {lo[0], lo[1], hi[0], hi[1]};
                    O[et] = MFMA32(__builtin_bit_cast(bf16x8, w), pb, O[et]);
                }
            }
            }
        }
        if (kt > 1) { const int sn = (it + 2) & 3; AT_STORE(at_k(sn), at_v(sn), at_c(sn)); }
        if (it == 3) { float v = Bi - m;
#pragma unroll
            for (int mm = 32; mm >= 1; mm >>= 1) v = fmaxf(v, __shfl_xor(v, mm));
            if (lane == 0) *(LAS float*)(lds + AT_END + wid * 4) = v; }
        if (it & 1) __syncthreads();
        if (it == 3) { float v = *(LAS const float*)(lds + AT_END);
#pragma unroll
            for (int w = 1; w < 8; ++w) v = fmaxf(v, *(LAS const float*)(lds + AT_END + w * 4));
            thresh = v + 40.f; }
    }
#undef AT_LOAD
#undef AT_STORE
    const float il = 1.f / l;
    __syncthreads();
    LAS unsigned char* tw = lds + wid * (32 * 264);
#pragma unroll
    for (int et = 0; et < 4; ++et)
#pragma unroll
        for (int g4 = 0; g4 < 4; ++g4) { const int e0 = et * 32 + 8 * g4 + 4 * hh;
            *(LAS u32x2*)(tw + r * 264 + e0 * 2) = (u32x2){pk_bf16(O[et][4 * g4] * il, O[et][4 * g4 + 1] * il), pk_bf16(O[et][4 * g4 + 2] * il, O[et][4 * g4 + 3] * il)}; }
#pragma unroll
    for (int c = 0; c < 8; ++c) { const int chunk = c * 64 + lane; const int tr = chunk >> 4, ec = (chunk & 15) * 8;
        const u32x2 ya = *(LAS const u32x2*)(tw + tr * 264 + ec * 2), yb = *(LAS const u32x2*)(tw + tr * 264 + ec * 2 + 8);
        *(u32x4*)(y + (size_t)(I0 + wid * 32 + tr) * LDK + 2048 + h * 128 + ec) = (u32x4){ya[0], ya[1], yb[0], yb[1]}; }
}

DI void phase_mixer(const Args& a, LAS unsigned char* lds, int qslot = 0) {
    unsigned* qhead = (unsigned*)(a.ws + WS_CTL) + CW_QUEUE + 64 * qslot;
    LAS unsigned* bc = (LAS unsigned*)(lds + LDS_MISC_OFF);
    for (;;) {
        if (a.wid == 0 && lane_id() == 0) *bc = atomicAdd(qhead, 1u);
        __syncthreads();
        const unsigned it = *bc;
        __syncthreads();
        if (it >= 64u + 2048u) break;
        if (it < 64u) ret_scan_item(a, (int)it);
        else if (it < 64u + 1024u) { const unsigned k = it - 64u; attn_unit(a, (int)(k & 15u), 63 - (int)(k >> 4), lds); }
        else { const unsigned k = it - 64u - 1024u; ret_scan_wait(a, (int)(k & 7u)); ret_out_unit(a, (int)(k >> 3), (int)(k & 7u), lds); }
    }
}

DI void phase_fox_norm(const Args& a) {
    const int wid = a.wid, lane = lane_id(), tid = wid * 64 + lane;
    bf16_t* y = (bf16_t*)(a.ws + WS_H1); const float* g = a.in[I_FNG];
    for (int row = blockIdx.x * 8 + wid; row < T; row += gridDim.x * 8) {
        bf16_t* yr = y + (size_t)row * LDK + 2048;
        u32x4 v[4]; float ss = 0.f;
#pragma unroll
        for (int c = 0; c < 4; ++c) { v[c] = *(const u32x4*)(yr + c * 512 + lane * 8);
#pragma unroll
            for (int j = 0; j < 4; ++j) { const float lo = bf_lo(v[c][j]), hi = bf_hi(v[c][j]); ss += lo * lo + hi * hi; } }
        ss = wave_sum(ss);
        const float rs = rsqrtf(ss * (1.f / 2048.f) + EPS);
#pragma unroll
        for (int c = 0; c < 4; ++c) { const int col = c * 512 + lane * 8; const f32x4 g0 = *(const f32x4*)(g + col), g1 = *(const f32x4*)(g + col + 4);
            u32x4 w = {pk_bf16(bf_lo(v[c][0]) * rs * g0[0], bf_hi(v[c][0]) * rs * g0[1]), pk_bf16(bf_lo(v[c][1]) * rs * g0[2], bf_hi(v[c][1]) * rs * g0[3]),
                       pk_bf16(bf_lo(v[c][2]) * rs * g1[0], bf_hi(v[c][2]) * rs * g1[1]), pk_bf16(bf_lo(v[c][3]) * rs * g1[2], bf_hi(v[c][3]) * rs * g1[3])};
            *(u32x4*)(yr + col) = w; }
    }
}

DI void ce_desc(float& x, float& y) { const float hi = fmaxf(x, y), lo = fminf(x, y); x = hi; y = lo; }
DI void sort16_desc(float (&v)[16]) {
#pragma unroll
    for (int k = 2; k <= 16; k <<= 1)
#pragma unroll
        for (int j = k >> 1; j > 0; j >>= 1)
#pragma unroll
            for (int i = 0; i < 16; ++i) { const int l = i ^ j; if (l > i) { if ((i & k) == 0) ce_desc(v[i], v[l]); else ce_desc(v[l], v[i]); } }
}
DI void merge16_desc(float (&x)[16], const float (&y)[16]) {
#pragma unroll
    for (int i = 0; i < 16; ++i) x[i] = fmaxf(x[i], y[15 - i]);
#pragma unroll
    for (int j = 8; j > 0; j >>= 1)
#pragma unroll
        for (int i = 0; i < 16; ++i) { const int l = i ^ j; if (l > i) ce_desc(x[i], x[l]); }
}
DI float tag_low(float v, unsigned mask, unsigned tag) { return __uint_as_float((__float_as_uint(v) & ~mask) | tag); }

constexpr int PE_EIDX = 0, PE_GATE = 16384, PE_A = 32768, PE_LIST = 49152, PE_SH = LDS_MISC_OFF + 64, PE_PSUM = PE_SH + 256;
constexpr size_t WS_HQ = WS_KV;
constexpr int PEER_SLICE_SHIFT = 9;

DI void peer_route(const Args& a, int t0, int rowbase, LAS unsigned char* lds) {
    const int wid = a.wid, lane = lane_id(), r = lane & 31, hh = lane >> 5;
    const bf16_t* qp = (const bf16_t*)(a.ws + WS_QP); const bf16_t* skb = (const bf16_t*)(a.ws + WS_SKB);
    {
        float top[2][16];
#pragma unroll
        for (int p = 0; p < 2; ++p) {
            bf16x8 qf[8];
            const bf16_t* qr = qp + (size_t)(t0 + r) * 2048 + wid * 256 + p * 128 + hh * 8;
#pragma unroll
            for (int s = 0; s < 8; ++s) qf[s] = *(const bf16x8*)(qr + s * 16);
            float best[16];
            bf16x8 kf[8];
            { const bf16_t* kr = skb + (size_t)((wid * 2 + p) * 128 + r) * 128 + hh * 8;
#pragma unroll
              for (int s = 0; s < 8; ++s) kf[s] = *(const bf16x8*)(kr + s * 16); }
#pragma unroll 1
            for (int kt = 0; kt < 4; ++kt) {
                f32x16 sc;
#pragma unroll
                for (int i = 0; i < 16; ++i) sc[i] = 0.f;
#pragma unroll
                for (int s = 0; s < 8; ++s) sc = MFMA32(kf[s], qf[s], sc);
                { const int kn = kt < 3 ? kt + 1 : 3; const bf16_t* kr = skb + (size_t)((wid * 2 + p) * 128 + kn * 32 + r) * 128 + hh * 8;
#pragma unroll
                  for (int s = 0; s < 8; ++s) kf[s] = *(const bf16x8*)(kr + s * 16); }
                __builtin_amdgcn_sched_barrier(0);
                float g[16];
#pragma unroll
                for (int i = 0; i < 16; ++i) g[i] = tag_low(sc[i], 127u, (unsigned)(kt * 32 + crow(i, hh)));
                sort16_desc(g);
                if (kt == 0) {
#pragma unroll
                    for (int i = 0; i < 16; ++i) best[i] = g[i];
                } else merge16_desc(best, g);
            }
            float oth[16];
#pragma unroll
            for (int i = 0; i < 16; ++i) oth[i] = swap32_other(best[i], hh);
            merge16_desc(best, oth);
#pragma unroll
            for (int i = 0; i < 16; ++i) top[p][i] = best[i];
        }
        LAS unsigned* lst = (LAS unsigned*)(lds + PE_LIST) + (wid * 32 + r) * 32;
        if (hh == 0) {
#pragma unroll
            for (int i = 0; i < 16; ++i) { lst[i] = __float_as_uint(top[0][i]) & 127u; lst[16 + i] = __float_as_uint(top[1][i]) & 127u; }
        }
        float cg[4][16]; int cnt = 0;
#pragma unroll
        for (int i = 0; i < 16; ++i)
#pragma unroll
            for (int j = 0; j < 16; ++j) if ((i + 1) * (j + 1) <= 16) { cg[cnt >> 4][cnt & 15] = tag_low(top[0][i] + top[1][j], 255u, (unsigned)(i * 16 + j)); ++cnt; }
#pragma unroll
        for (int k = 50; k < 64; ++k) cg[k >> 4][k & 15] = -__builtin_inff();
        sort16_desc(cg[0]); sort16_desc(cg[1]); sort16_desc(cg[2]); sort16_desc(cg[3]);
        merge16_desc(cg[0], cg[1]); merge16_desc(cg[2], cg[3]); merge16_desc(cg[0], cg[2]);
        float ex[16], z = 0.f;
#pragma unroll
        for (int k = 0; k < 16; ++k) { ex[k] = __expf(cg[0][k] - cg[0][0]); z += ex[k]; }
        const float iz = 1.f / z;
        asm volatile("s_waitcnt lgkmcnt(0)" ::: "memory");
        LAS int* eo = (LAS int*)(lds + PE_EIDX) + (rowbase + r) * 128 + wid * 16; LAS float* go = (LAS float*)(lds + PE_GATE) + (rowbase + r) * 128 + wid * 16;
#pragma unroll
        for (int k = 0; k < 16; ++k) if ((k >> 3) == hh) { const unsigned code = __float_as_uint(cg[0][k]) & 255u;
            const unsigned i1 = lst[code >> 4], i2 = lst[16 + (code & 15u)];
            eo[k] = (int)(i1 * 128u + i2); go[k] = ex[k] * iz; }
    }
}

DI int reduce4(const int (&d)[4], int lane) {
    const bool b0 = lane & 1, b1 = lane & 2;
    const int t0v = (b0 ? d[1] : d[0]) + __shfl_xor(b0 ? d[0] : d[1], 1);
    const int t1v = (b0 ? d[3] : d[2]) + __shfl_xor(b0 ? d[2] : d[3], 1);
    int tot = (b1 ? t1v : t0v) + __shfl_xor(b1 ? t0v : t1v, 2);
#pragma unroll
    for (int m = 4; m <= 32; m <<= 1) tot += __shfl_xor(tot, m);
    return tot;
}
DI void pu_issue(const unsigned char* uq, LAS const unsigned* lst, int b, unsigned ulane, unsigned (&ew)[4], u32x4 (&r)[4][2]) {
    const u32x4 w = *(LAS const u32x4*)(lst + 4 * b);
#pragma unroll
    for (int i = 0; i < 4; ++i) { ew[i] = (unsigned)__builtin_amdgcn_readfirstlane((int)w[i]);
        const unsigned char* rp = uq + (size_t)(ew[i] & 16383u) * 2048 + ulane * 16u;
        r[i][0] = *(const u32x4*)rp; r[i][1] = *(const u32x4*)(rp + 1024); }
}
DI int pu_dot(const u32x4 (&r)[2], const u32x4 (&h)[4]) {
    int ah = 0, al = 0;
#pragma unroll
    for (int c = 0; c < 2; ++c)
#pragma unroll
        for (int i = 0; i < 4; ++i) { ah = __builtin_amdgcn_sdot8((int)r[c][i], (int)h[c][i], ah, false); al = __builtin_amdgcn_sdot8((int)r[c][i], (int)h[2 + c][i], al, false); }
    return ah * 16 + al;
}
DI void pu_compute(const unsigned (&ew)[4], const u32x4 (&r)[4][2], const u32x4 (&hq)[4][4], LAS int* abase, LAS const unsigned* lst, int b, int lane) {
    int d[4];
#pragma unroll
    for (int i = 0; i < 4; ++i) { const unsigned q = (ew[i] >> 14) & 3u;
        if (q == 0u) d[i] = pu_dot(r[i], hq[0]); else if (q == 1u) d[i] = pu_dot(r[i], hq[1]); else if (q == 2u) d[i] = pu_dot(r[i], hq[2]); else d[i] = pu_dot(r[i], hq[3]); }
    const int tot = reduce4(d, lane);
    const unsigned wl = lst[4 * b + (lane & 3)];
    if (lane < 4) abase[((wl >> 14) & 3u) * 128u + (wl >> 16)] = tot;
}
constexpr int PE_VT = 49152, PE_PEXP = 114688, PE_G2 = 132096;
constexpr int PE_EPI = 122880;
constexpr int PE_PSQ = PE_PSUM + 128;
DI int vswz(int row) { return ((row >> 1) & 1) * 2 + ((row >> 3) & 1) * 4; }
DI void pv_load(const unsigned char* vqj, int tok, int pb, LAS unsigned char* lds, int lane, u32x4 (&vr)[4]) {
    const int g = lane >> 3, c = lane & 7;
#pragma unroll
    for (int i = 0; i < 4; ++i) { const int e = *((LAS const int*)(lds + PE_EIDX) + tok * 128 + pb * 32 + i * 8 + g);
        vr[i] = *(const u32x4*)(vqj + (size_t)e * 128 + (unsigned)(c * 16)); }
}
DI void pv_write(LAS unsigned char* tile, int lane, const u32x4 (&vr)[4]) {
    const int g = lane >> 3, c = lane & 7;
#pragma unroll
    for (int i = 0; i < 4; ++i) { const int row = i * 8 + g; *(LAS u32x4*)(tile + row * 128 + ((c ^ vswz(row)) * 16)) = vr[i]; }
}
DI void pv_read(LAS unsigned char* tile, int lane, u32x4 (&raw)[4]) {
    const int kg = lane >> 4, n = lane & 15;
    const int rowl = kg * 8 + (n >> 2), pc = n & 3, sw = vswz(rowl);
#pragma unroll
    for (int cb = 0; cb < 4; ++cb) {
        LAS unsigned char* p0 = tile + rowl * 128 + (((2 * cb + (pc >> 1)) ^ sw) * 16) + 8 * (pc & 1);
        const s16x4 r0 = __builtin_amdgcn_ds_read_tr16_b64_v4i16((LAS s16x4*)p0);
        const s16x4 r1 = __builtin_amdgcn_ds_read_tr16_b64_v4i16((LAS s16x4*)(p0 + 4 * 128));
        const u32x2 w0 = __builtin_bit_cast(u32x2, r0), w1 = __builtin_bit_cast(u32x2, r1);
        raw[cb] = (u32x4){w0[0], w0[1], w1[0], w1[1]};
    }
}
DI void pv_mac(int tok, int pb, LAS unsigned char* lds, int lane, const u32x4 (&raw)[4], i32x4v (&acc)[2][4]) {
    const int kg = lane >> 4, n = lane & 15;
    u32x4 ae = *(LAS const u32x4*)(lds + PE_PEXP + (tok * 128 + pb * 32 + kg * 8) * 2);
    const int shl = n == 1 ? 8 : 0;
    ae = (u32x4){ae[0] << shl, ae[1] << shl, ae[2] << shl, ae[3] << shl};
    if (n > 1) ae = (u32x4){0u, 0u, 0u, 0u};
#pragma unroll
    for (int cb = 0; cb < 4; ++cb) {
        const i32x4v lo = {(int)(raw[cb][0] & 0x0F0F0F0Fu), (int)(raw[cb][1] & 0x0F0F0F0Fu), (int)(raw[cb][2] & 0x0F0F0F0Fu), (int)(raw[cb][3] & 0x0F0F0F0Fu)};
        acc[0][cb] = __builtin_amdgcn_mfma_i32_16x16x64_i8(__builtin_bit_cast(i32x4v, ae), lo, acc[0][cb], 0, 0, 0);
        acc[1][cb] = __builtin_amdgcn_mfma_i32_16x16x64_i8(__builtin_bit_cast(i32x4v, ae), __builtin_bit_cast(i32x4v, raw[cb]), acc[1][cb], 0, 0, 0);
    }
}
DI f32x4 pv_loadx(const Args& a, int t, int j, int lane) { const u32x2 w = *(const u32x2*)((const bf16_t*)(a.ws + WS_X1B) + (size_t)t * X1P + j * 256 + lane * 4); return (f32x4){bf_lo(w[0]), bf_hi(w[0]), bf_lo(w[1]), bf_hi(w[1])}; }
DI float pv_epi(const Args& a, int t, int tok, int j, LAS unsigned char* lds, LAS unsigned char* ebuf, int lane, const i32x4v (&acc)[2][4], const f32x4 x1) {
    const float sp = *((LAS const float*)(lds + PE_PSUM) + tok);
    const int corr = 8 * *((LAS const int*)(lds + PE_PSQ) + tok);
    if (lane < 16) {
#pragma unroll
        for (int i = 0; i < 8; ++i) { const int cb = i & 3;
            const int s0 = (i >> 2) ? (acc[1][cb][0] - acc[0][cb][0]) >> 4 : acc[0][cb][0] - corr, s1 = (i >> 2) ? (acc[1][cb][1] - acc[0][cb][1]) >> 4 : acc[0][cb][1] - corr;
            *(LAS u32x2*)(ebuf + (i * 32 + lane * 2) * 4) = (u32x2){(unsigned)s0, (unsigned)s1}; }
    }
    asm volatile("" ::: "memory");
    const i32x4v s4 = *(LAS const i32x4v*)(ebuf + lane * 16);
    const f32x4 g2 = *((LAS const f32x4*)(lds + PE_G2) + j * 64 + lane);
    const f32x4 y = {x1[0] + g2[0] * ((float)s4[0] * sp), x1[1] + g2[1] * ((float)s4[1] * sp), x1[2] + g2[2] * ((float)s4[2] * sp), x1[3] + g2[3] * ((float)s4[3] * sp)};
    *(u32x2*)((bf16_t*)(a.ws + WS_X1B) + (size_t)t * X1P + j * 256 + lane * 4) = (u32x2){pk_bf16(y[0], y[1]), pk_bf16(y[2], y[3])};
    asm volatile("" ::: "memory");
    return y[0] * y[0] + y[1] * y[1] + y[2] * y[2] + y[3] * y[3];
}

DI void peer_tile(const Args& a, int tile, LAS unsigned char* lds) {
    const int wid = a.wid;
    const int t0 = tile * 32;
    peer_route(a, t0, 0, lds);
    __syncthreads();
    const bf16_t* h2 = (const bf16_t*)(a.ws + WS_H2); const unsigned char* uq = a.ws + WS_UB;
    const float* su = (const float*)(a.ws + WS_SU); const float* sv = (const float*)(a.ws + WS_SV);
    int lane = lane_id(); unsigned ulane = (unsigned)lane;
    unsigned char* hqg = a.ws + WS_HQ;
    u32x4 hnx[8];
#pragma unroll
    for (int c = 0; c < 4; ++c) { hnx[2 * c] = *(const u32x4*)(h2 + (size_t)(t0 + wid * 4) * LDK + c * 1024 + ulane * 16u); hnx[2 * c + 1] = *(const u32x4*)(h2 + (size_t)(t0 + wid * 4) * LDK + c * 1024 + ulane * 16u + 8u); }
#pragma unroll 1
    for (int q = 0; q < 4; ++q) {
        lane = lane_id(); ulane = (unsigned)lane;
        const int tok = wid * 4 + q, t = t0 + tok;
        u32x4 hb[8]; float mx = 0.f;
#pragma unroll
        for (int c = 0; c < 8; ++c) hb[c] = hnx[c];
        { const int tn = t0 + wid * 4 + (q < 3 ? q + 1 : 3);
#pragma unroll
          for (int c = 0; c < 4; ++c) { hnx[2 * c] = *(const u32x4*)(h2 + (size_t)tn * LDK + c * 1024 + ulane * 16u); hnx[2 * c + 1] = *(const u32x4*)(h2 + (size_t)tn * LDK + c * 1024 + ulane * 16u + 8u); } }
        __builtin_amdgcn_sched_barrier(0);
#pragma unroll
        for (int c = 0; c < 8; ++c)
#pragma unroll
            for (int w = 0; w < 4; ++w) mx = fmaxf(mx, fmaxf(fabsf(bf_lo(hb[c][w])), fabsf(bf_hi(hb[c][w]))));
#pragma unroll
        for (int m = 32; m >= 1; m >>= 1) mx = fmaxf(mx, __shfl_xor(mx, m));
        const float inv = mx > 0.f ? 119.f / mx : 0.f;
#pragma unroll
        for (int c = 0; c < 2; ++c) { u32x4 hvh, hvl;
#pragma unroll
            for (int i = 0; i < 4; ++i) { unsigned wh = 0u, wl = 0u;
#pragma unroll
                for (int m = 0; m < 4; ++m) {
                    const unsigned wa = hb[2 * c + (i >> 1)][(i & 1) * 2 + (m >> 1)], wb = hb[2 * c + 4 + (i >> 1)][(i & 1) * 2 + (m >> 1)];
                    const int qa = (int)rintf(((m & 1) ? bf_hi(wa) : bf_lo(wa)) * inv), qb = (int)rintf(((m & 1) ? bf_hi(wb) : bf_lo(wb)) * inv);
                    const int ha = (qa + 8) >> 4, hbq = (qb + 8) >> 4;
                    wh |= ((unsigned)(ha & 15) << (8 * m)) | ((unsigned)(hbq & 15) << (8 * m + 4));
                    wl |= ((unsigned)((qa - 16 * ha) & 15) << (8 * m)) | ((unsigned)((qb - 16 * hbq) & 15) << (8 * m + 4)); }
                hvh[i] = wh; hvl[i] = wl; }
            *(u32x4*)(hqg + (size_t)t * 4096 + c * 1024 + ulane * 16u) = hvh; *(u32x4*)(hqg + (size_t)t * 4096 + (2 + c) * 1024 + ulane * 16u) = hvl; }
        if (lane == 0) *((LAS float*)(lds + PE_SH) + tok) = mx * (1.f / 119.f);
    }
    asm volatile("s_waitcnt vmcnt(0)" ::: "memory");
    __builtin_amdgcn_fence(__ATOMIC_ACQUIRE, "agent");
    lane = lane_id(); ulane = (unsigned)lane;
    u32x4 hq[4][4];
#pragma unroll
    for (int q = 0; q < 4; ++q)
#pragma unroll
        for (int c = 0; c < 4; ++c) hq[q][c] = *(const u32x4*)(hqg + (size_t)(t0 + wid * 4 + q) * 4096 + c * 1024 + ulane * 16u);
    {
        LAS unsigned* lst = (LAS unsigned*)(lds + PE_VT + wid * 8192);
        {
            int ev[8];
#pragma unroll
            for (int r = 0; r < 8; ++r) ev[r] = *((LAS const int*)(lds + PE_EIDX) + (wid * 4 + (r >> 1)) * 128 + (r & 1) * 64 + lane);
            { float suv[8], svv[8];
#pragma unroll
              for (int r = 0; r < 8; ++r) { suv[r] = su[ev[r]]; svv[r] = sv[ev[r]]; }
#pragma unroll
              for (int r = 0; r < 8; ++r) { const int idx = (wid * 4 + (r >> 1)) * 128 + (r & 1) * 64 + lane;
                  *((LAS float*)(lds + PE_VT + wid * 8192 + 2048) + (r >> 1) * 128 + (r & 1) * 64 + lane) = suv[r];
                  LAS float* gp = (LAS float*)(lds + PE_GATE) + idx; *gp = *gp * svv[r]; } }
            const unsigned long long ltm = (1ull << lane) - 1ull;
            int base = 0;
#pragma unroll 1
            for (int j = 0; j < (16384 >> PEER_SLICE_SHIFT); ++j) {
#pragma unroll
                for (int r = 0; r < 8; ++r) { const bool in = (ev[r] >> PEER_SLICE_SHIFT) == j; const unsigned long long m = __ballot(in);
                    if (in) lst[base + __popcll(m & ltm)] = (unsigned)ev[r] | ((unsigned)(r >> 1) << 14) | ((unsigned)((r & 1) * 64 + lane) << 16);
                    base += __popcll(m); }
            }
        }
        asm volatile("s_waitcnt lgkmcnt(0)" ::: "memory");
        LAS int* arow = (LAS int*)(lds + PE_A) + wid * 4 * 128;
        unsigned ewA[4], ewB[4], ewC[4]; u32x4 rA[4][2], rB[4][2], rC[4][2];
        pu_issue(uq, lst, 0, ulane, ewA, rA); pu_issue(uq, lst, 1, ulane, ewB, rB); pu_issue(uq, lst, 2, ulane, ewC, rC);
#define SB __builtin_amdgcn_sched_barrier(0)
#pragma unroll 1
        for (int b = 0; b < 129; b += 3) {
            pu_compute(ewA, rA, hq, arow, lst, b, lane); SB; pu_issue(uq, lst, b + 3 < 127 ? b + 3 : 127, ulane, ewA, rA); SB;
            if (b + 1 < 128) pu_compute(ewB, rB, hq, arow, lst, b + 1, lane);
            SB; pu_issue(uq, lst, b + 4 < 127 ? b + 4 : 127, ulane, ewB, rB); SB;
            if (b + 2 < 128) pu_compute(ewC, rC, hq, arow, lst, b + 2, lane);
            SB; pu_issue(uq, lst, b + 5 < 127 ? b + 5 : 127, ulane, ewC, rC); SB;
        }
#undef SB
        asm volatile("s_waitcnt lgkmcnt(0)" ::: "memory");
    }
#pragma unroll 1
    for (int q = 0; q < 4; ++q) {
        const int tok = wid * 4 + q;
        const float sh = *((LAS const float*)(lds + PE_SH) + tok);
        float pp[2];
#pragma unroll
        for (int hf = 0; hf < 2; ++hf) { const int k = hf * 64 + lane;
            const int ai = *((LAS const int*)(lds + PE_A) + tok * 128 + k);
            const float sue = *((LAS const float*)(lds + PE_VT + wid * 8192 + 2048) + q * 128 + k);
            pp[hf] = gelu_tanh((float)ai * sue * sh) * *((LAS const float*)(lds + PE_GATE) + tok * 128 + k); }
        float mx = fmaxf(fabsf(pp[0]), fabsf(pp[1]));
#pragma unroll
        for (int m = 32; m >= 1; m >>= 1) mx = fmaxf(mx, __shfl_xor(mx, m));
        const float inv = mx > 0.f ? 127.f / mx : 0.f;
        int qs = 0;
#pragma unroll
        for (int hf = 0; hf < 2; ++hf) { const int qi = (int)rintf(pp[hf] * inv); qs += qi; *((LAS unsigned short*)(lds + PE_PEXP) + tok * 128 + hf * 64 + lane) = (unsigned short)(qi & 255); }
#pragma unroll
        for (int m = 32; m >= 1; m >>= 1) qs += __shfl_xor(qs, m);
        if (lane == 0) { *((LAS float*)(lds + PE_PSUM) + tok) = mx * (1.f / 127.f); *((LAS int*)(lds + PE_PSQ) + tok) = qs; }
    }
    float ssq[4] = {0.f, 0.f, 0.f, 0.f};
    {
        const int tk = wid * 4, tg = t0 + wid * 4;
        LAS unsigned char* vt = lds + PE_VT + wid * 8192;
        LAS unsigned char* ebuf = lds + PE_EPI + wid * 1024;
        const unsigned char* vq = a.ws + WS_VB;
        u32x4 vb[8][4]; f32x4 xa, xb;
        lane = lane_id();
        xa = pv_loadx(a, tg, 0, lane);
#pragma unroll
        for (int pb = 0; pb < 4; ++pb) pv_load(vq, tk, pb, lds, lane, vb[pb]);
        xb = pv_loadx(a, tg + 1, 0, lane);
#pragma unroll
        for (int pb = 0; pb < 4; ++pb) pv_load(vq, tk + 1, pb, lds, lane, vb[4 + pb]);
        pv_write(vt, lane, vb[0]);
        pv_load(vq, tk + 2, 0, lds, lane, vb[0]);
#pragma unroll 1
        for (int j = 0; j < 16; ++j) {
            lane = lane_id();
            const int jn = j < 15 ? j + 1 : 15;
            const unsigned char* vqj = vq + (size_t)j * (16384 * 128);
            const unsigned char* vqn = vq + (size_t)jn * (16384 * 128);
#define SB do {} while (0)
#pragma unroll
            for (int q = 0; q < 4; ++q) {
                i32x4v acc[2][4];
#pragma unroll
                for (int i = 0; i < 8; ++i) acc[i >> 2][i & 3] = (i32x4v){0, 0, 0, 0};
#pragma unroll
                for (int pb = 0; pb < 4; ++pb) {
                    const int i = q * 4 + pb, in = (i + 1) & 15;
                    u32x4 raw[4];
                    pv_read(vt + (i & 1) * 4096, lane, raw);
                    asm volatile("" ::: "memory"); SB;
                    pv_write(vt + ((i + 1) & 1) * 4096, lane, vb[in & 7]);
                    asm volatile("" ::: "memory"); SB;
                    {
                        const int qn = (in >> 2) + 2, pbn = in & 3;
                        const bool nexts = (i == 15) || (qn >= 4);
                        const int qq = (i == 15) ? 2 : (qn & 3);
                        pv_load(nexts ? vqn : vqj, tk + qq, pbn, lds, lane, vb[in & 7]);
                    }
                    SB;
                    pv_mac(tk + q, pb, lds, lane, raw, acc); SB;
                    if (pb == 3) { ssq[q] += pv_epi(a, tg + q, tk + q, j, lds, ebuf, lane, acc, (q & 1) ? xb : xa); SB;
                        const f32x4 xn = q < 2 ? pv_loadx(a, tg + q + 2, j, lane) : pv_loadx(a, tg + q - 2, jn, lane);
                        if (q & 1) xb = xn; else xa = xn; SB; }
                }
            }
#undef SB
        }
    }
    asm volatile("s_waitcnt vmcnt(0)" ::: "memory");
    __builtin_amdgcn_fence(__ATOMIC_ACQUIRE, "agent");
    const float* fg = a.in[I_FG];
#pragma unroll
    for (int q = 0; q < 4; ++q) {
        lane = lane_id(); ulane = (unsigned)lane;
        const float ss = wave_sum(ssq[q]);
        const float rs = rsqrtf(ss * (1.f / 4096.f) + EPS);
        const bf16_t* xr = (const bf16_t*)(a.ws + WS_X1B) + (size_t)(t0 + wid * 4 + q) * X1P;
        float* orow = a.out + (size_t)(t0 + wid * 4 + q) * 4096;
#pragma unroll
        for (int c = 0; c < 16; ++c) { const unsigned col = (unsigned)c * 256u + ulane * 4u;
            const u32x2 w = *(const u32x2*)(xr + col); const f32x4 f = *(const f32x4*)(fg + col);
            *(f32x4*)(orow + col) = (f32x4){bf_lo(w[0]) * rs * f[0], bf_hi(w[0]) * rs * f[1], bf_lo(w[1]) * rs * f[2], bf_hi(w[1]) * rs * f[3]};
            if ((c & 3) == 3) asm volatile("" ::: "memory"); }
    }
    __syncthreads();
}
DI void phase_peer(const Args& a, LAS unsigned char* lds) {
    { const int tid = a.wid * 64 + lane_id(); const float* gate2 = (const float*)(a.ws + WS_MOD) + 5 * 4096;
      for (int i = tid; i < 1024; i += NTHREADS) *((LAS f32x4*)(lds + PE_G2) + i) = *((const f32x4*)gate2 + i); }
    for (int tile = blockIdx.x; tile < T / 32; tile += gridDim.x) peer_tile(a, tile, lds);
}

constexpr int N_PHASES = 12;
__global__ void __launch_bounds__(NTHREADS, 2) mk_fwd(Args a_in) {
    Args a = a_in; a.wid = __builtin_amdgcn_readfirstlane(threadIdx.x >> 6);
    extern __shared__ __attribute__((aligned(16))) unsigned char shm_raw[];
    LAS unsigned char* lds = (LAS unsigned char*)shm_raw;
    if (threadIdx.x == 0) *(LAS u32x4*)(lds + LDS_BAR_OFF) = (u32x4){0u, 0u, 0u, 0u};
    __syncthreads();
    unsigned* ctl = (unsigned*)(a.ws + WS_CTL);
    XcdBarrier bar = xcd_barrier_post(ctl + CW_BAR, (volatile LAS unsigned*)(lds + LDS_BAR_OFF)); bar.wid = a.wid;
    const float* mod = (const float*)(a.ws + WS_MOD);
#ifdef MK_ONLY
#define RUN(k) ((k) == MK_ONLY)
#else
#define RUN(k) (a.ph_lo <= (k) && (k) < a.ph_hi)
#endif
#define SEAM(k) do { if (a.ph_lo <= (k) && (k) + 1 < a.ph_hi) xcd_barrier(bar); } while (0)
    if (RUN(0)) phase_prologue(a, lds);
    SEAM(0);
    if (RUN(1)) phase_norm_mod(a, a.in[I_X], a.in[I_N1G], mod, mod + 4096, (bf16_t*)(a.ws + WS_H1), lds);
    SEAM(1);
    if (RUN(2)) { pg8::StaticOrder S; S.init(T, NPAD, gridDim.x, blockIdx.x);
        pg8::gemm_phase(a.wid, lds, pg8::Gemm{(const bf16_t*)(a.ws + WS_H1), (const bf16_t*)(a.ws + WS_WIN), T, NPAD, 4096, LDK}, S, pg8::EpiProj{(bf16_t*)(a.ws + WS_PROJ), NPAD, (bf16_t*)(a.ws + WS_RVT), (bf16_t*)(a.ws + WS_FVT), (bf16_t*)(a.ws + WS_RQ), (bf16_t*)(a.ws + WS_RK), (bf16_t*)(a.ws + WS_RKT), (const float*)(a.ws + WS_COS), (const float*)(a.ws + WS_SIN)});
        phase_ff(a, lds);
    }
    SEAM(2);
    if (RUN(3)) phase_prep(a, lds);
    if (RUN(4)) phase_ret_kv(a, lds);
    SEAM(4);
    if (RUN(6)) phase_mixer(a, lds);
    SEAM(6);
    if (RUN(7)) phase_fox_norm(a);
    SEAM(7);
    if (RUN(8)) { pg8::StaticOrder S; S.init(T, 4096, gridDim.x, blockIdx.x);
        pg8::gemm_phase(a.wid, lds, pg8::Gemm{(const bf16_t*)(a.ws + WS_H1), (const bf16_t*)(a.ws + WS_WOUT), T, 4096, 4096, LDK}, S, pg8::EpiResGate{(bf16_t*)(a.ws + WS_X1B), a.in[I_X], mod + 2 * 4096, 4096, X1P});
    }
    SEAM(8);
    if (RUN(9)) phase_norm_mod_bf(a, (const bf16_t*)(a.ws + WS_X1B), a.in[I_N2G], mod + 3 * 4096, mod + 4 * 4096, (bf16_t*)(a.ws + WS_H2), lds);
    SEAM(9);
    if (RUN(10)) { pg8::StaticOrder S; S.init(T, 2048, gridDim.x, blockIdx.x);
        pg8::gemm_phase(a.wid, lds, pg8::Gemm{(const bf16_t*)(a.ws + WS_H2), (const bf16_t*)(a.ws + WS_WPQ), T, 2048, 4096, LDK}, S, pg8::EpiBf16{(bf16_t*)(a.ws + WS_QP), 2048});
    }
    SEAM(10);
    if (RUN(11)) phase_peer(a, lds);
#undef RUN
#undef SEAM
}

#ifndef MK_N_LAUNCHES
#define MK_N_LAUNCHES 1
#endif
extern "C" void kernel_launch(void* const* d_in, const int* in_sizes, int n_in, void* d_out, int out_size, void* d_ws, size_t ws_size, hipStream_t stream) {
    static int grid = 0;
    if (grid == 0) {
        if (n_in != 17 || out_size != T * D || ws_size < WS_END) { fprintf(stderr, "kernel_launch: unexpected shapes (n_in %d, out %d, ws %zu < %zu)\n", n_in, out_size, ws_size, (size_t)WS_END); grid = -1; return; }
        int dev = 0, cus = 0, per_cu = 0;
        if (hipGetDevice(&dev) != hipSuccess || hipDeviceGetAttribute(&cus, hipDeviceAttributeMultiprocessorCount, dev) != hipSuccess) { grid = -1; return; }
        if (hipFuncSetAttribute((const void*)mk_fwd, hipFuncAttributeMaxDynamicSharedMemorySize, LDS_BYTES) != hipSuccess) { fprintf(stderr, "kernel_launch: hipFuncSetAttribute failed\n"); grid = -1; return; }
        if (hipOccupancyMaxActiveBlocksPerMultiprocessor(&per_cu, (const void*)mk_fwd, NTHREADS, LDS_BYTES) != hipSuccess || per_cu < 1) { fprintf(stderr, "kernel_launch: occupancy query says %d\n", per_cu); (void)hipGetLastError(); per_cu = 1; }
        grid = cus;
    }
    if (grid < 0) return;
    (void)in_sizes;
    (void)hipMemsetAsync((char*)d_ws + WS_CTL, 0, CTL_BYTES, stream);
    Args a{};
    for (int i = 0; i < 17; ++i) a.in[i] = (const float*)d_in[i];
    a.out = (float*)d_out; a.ws = (unsigned char*)d_ws;
    for (int li = 0; li < MK_N_LAUNCHES; ++li) {
        a.ph_lo = li * N_PHASES / MK_N_LAUNCHES; a.ph_hi = (li + 1) * N_PHASES / MK_N_LAUNCHES;
        hipLaunchKernelGGL(mk_fwd, dim3(grid), dim3(NTHREADS), LDS_BYTES, stream, a);
    }
}
```
